# Optimizing an MI355X kernel written in HIP

```python
import jax, jax.numpy as jnp
from jax import lax
import numpy as np

D_MODEL = 1024
BATCH = 8
SEQ = 4096
DEPTH = 1

HEAD_DIM = 64
N_FOX_HEADS = 8
N_MOBA_HEADS = 8
FOX_WIDTH = N_FOX_HEADS * HEAD_DIM
MOBA_WIDTH = N_MOBA_HEADS * HEAD_DIM
MIX_WIDTH = FOX_WIDTH + MOBA_WIDTH
IN_COLS = 3 * FOX_WIDTH + N_FOX_HEADS + 3 * MOBA_WIDTH
FOX_Q_BLOCK = 128
MOBA_BLOCK = 256
MOBA_TOPK = 3
MOBA_Q_CHUNK = 16
ROPE_THETA = 500000.0
ROPE_DIM = HEAD_DIM // 4
N_GROUPS = 4
EXPERTS_PER_GROUP = 8
N_EXPERTS = N_GROUPS * EXPERTS_PER_GROUP
TOPK_IN_GROUP = 2
D_EXPERT = 256
EPS = 1e-6
F32 = jnp.float32

kernel_name = "hymba_fox_moba_hmoe_layer"


def rms_norm(x, g):
    xf = x.astype(F32)
    y = xf * lax.rsqrt(jnp.mean(xf * xf, axis=-1, keepdims=True) + EPS)
    return (y * g.astype(F32)).astype(x.dtype)


def to_heads(t, n_heads):
    b, s, _ = t.shape
    return t.reshape(b, s, n_heads, HEAD_DIM).transpose(0, 2, 1, 3)


def from_heads(t):
    b, h, s, d = t.shape
    return t.transpose(0, 2, 1, 3).reshape(b, s, h * d)


def partial_rotary(t):
    seq = t.shape[2]
    half = ROPE_DIM // 2
    inv_freq = ROPE_THETA ** (-jnp.arange(half, dtype=F32) / half)
    ang = jnp.arange(seq, dtype=F32)[:, None] * inv_freq[None, :]
    cos, sin = jnp.cos(ang), jnp.sin(ang)
    tr = t[..., :ROPE_DIM].astype(F32)
    t1, t2 = tr[..., :half], tr[..., half:]
    rot = jnp.concatenate([t1 * cos - t2 * sin, t2 * cos + t1 * sin], axis=-1).astype(t.dtype)
    return jnp.concatenate([rot, t[..., ROPE_DIM:]], axis=-1)


def forgetting_attention(q, k, v, log_f):
    b, h, s, d = q.shape
    nb = s // FOX_Q_BLOCK
    c = jnp.cumsum(log_f, axis=-1)
    q_blocks = q.reshape(b, h, nb, FOX_Q_BLOCK, d).transpose(2, 0, 1, 3, 4)
    c_blocks = c.reshape(b, h, nb, FOX_Q_BLOCK).transpose(2, 0, 1, 3)
    key_pos = jnp.arange(s)
    scale = HEAD_DIM ** -0.5

    def one_block(args):
        i, qb, cb = args
        sc = jnp.einsum('bhqd,bhkd->bhqk', qb, k, preferred_element_type=F32) * scale
        sc = sc + cb[..., :, None] - c[:, :, None, :]
        q_pos = i * FOX_Q_BLOCK + jnp.arange(FOX_Q_BLOCK)
        sc = jnp.where(key_pos[None, :] <= q_pos[:, None], sc, -jnp.inf)
        p = jax.nn.softmax(sc, axis=-1)
        return jnp.einsum('bhqk,bhkd->bhqd', p.astype(v.dtype), v)

    out = lax.map(one_block, (jnp.arange(nb), q_blocks, c_blocks))
    return out.transpose(1, 2, 0, 3, 4).reshape(b, h, s, d)


def moba_attention(q, k, v):
    b, h, s, d = q.shape
    nblk = -(-s // MOBA_BLOCK)
    pad = nblk * MOBA_BLOCK - s
    k_blk = jnp.pad(k, ((0, 0), (0, 0), (0, pad), (0, 0))).reshape(b, h, nblk, MOBA_BLOCK, d)
    v_blk = jnp.pad(v, ((0, 0), (0, 0), (0, pad), (0, 0))).reshape(b, h, nblk, MOBA_BLOCK, d)
    k_mean = jnp.mean(k_blk.astype(F32), axis=3)
    topk = min(MOBA_TOPK, nblk)
    nq = s // MOBA_Q_CHUNK
    q_chunks = q.reshape(b, h, nq, MOBA_Q_CHUNK, d).transpose(2, 0, 1, 3, 4)
    b_idx = jnp.arange(b)[:, None, None, None]
    h_idx = jnp.arange(h)[None, :, None, None]
    blk_ids = jnp.arange(nblk)
    scale = HEAD_DIM ** -0.5

    def one_chunk(args):
        i, qc = args
        q_pos = i * MOBA_Q_CHUNK + jnp.arange(MOBA_Q_CHUNK)
        own = q_pos[0] // MOBA_BLOCK
        gate = jnp.einsum('bhqd,bhnd->bhqn', qc.astype(F32), k_mean)
        gate = jnp.where(blk_ids < own, gate, -jnp.inf)
        _, sel = lax.top_k(gate, topk)
        sel_valid = sel < own
        k_sel = k_blk[b_idx, h_idx, sel]
        v_sel = v_blk[b_idx, h_idx, sel]
        s_sel = jnp.einsum('bhqd,bhqjkd->bhqjk', qc, k_sel, preferred_element_type=F32) * scale
        s_sel = jnp.where(sel_valid[..., None], s_sel, -jnp.inf)
        s_sel = s_sel.reshape(b, h, MOBA_Q_CHUNK, topk * MOBA_BLOCK)
        k_own = lax.dynamic_index_in_dim(k_blk, own, axis=2, keepdims=False)
        v_own = lax.dynamic_index_in_dim(v_blk, own, axis=2, keepdims=False)
        own_pos = own * MOBA_BLOCK + jnp.arange(MOBA_BLOCK)
        s_own = jnp.einsum('bhqd,bhkd->bhqk', qc, k_own, preferred_element_type=F32) * scale
        s_own = jnp.where(own_pos[None, :] <= q_pos[:, None], s_own, -jnp.inf)
        p = jax.nn.softmax(jnp.concatenate([s_sel, s_own], axis=-1), axis=-1)
        p_sel = p[..., :topk * MOBA_BLOCK].reshape(b, h, MOBA_Q_CHUNK, topk, MOBA_BLOCK)
        p_own = p[..., topk * MOBA_BLOCK:]
        return (jnp.einsum('bhqjk,bhqjkd->bhqd', p_sel.astype(v.dtype), v_sel)
                + jnp.einsum('bhqk,bhkd->bhqd', p_own.astype(v.dtype), v_own))

    out = lax.map(one_chunk, (jnp.arange(nq), q_chunks))
    return out.transpose(1, 2, 0, 3, 4).reshape(b, h, s, d)


def hierarchical_moe(h, w_rg, b_rg, w_re, b_re, w_gate, w_up, w_down):
    g_prob = jax.nn.softmax(jnp.einsum('bsd,dg->bsg', h, w_rg, preferred_element_type=F32)
                            + b_rg.astype(F32), axis=-1)
    g_top, g_idx = lax.top_k(g_prob, 1)
    e_logits = jnp.einsum('bsd,dge->bsge', h, w_re, preferred_element_type=F32) + b_re.astype(F32)
    e_logits = jnp.take_along_axis(e_logits, g_idx[..., None], axis=2)[..., 0, :]
    e_prob = jax.nn.softmax(e_logits, axis=-1)
    e_top, e_idx = lax.top_k(e_prob, TOPK_IN_GROUP)
    e_w = e_top / jnp.sum(e_top, axis=-1, keepdims=True) * g_top
    flat_idx = g_idx * EXPERTS_PER_GROUP + e_idx
    combine = jnp.sum(jax.nn.one_hot(flat_idx, N_EXPERTS, dtype=F32) * e_w[..., None], axis=-2)

    def per_sequence(args):
        hs, cs = args
        a = jnp.einsum('sd,edf->sef', hs, w_gate)
        u = jnp.einsum('sd,edf->sef', hs, w_up)
        act = jax.nn.silu(a) * u * cs[..., None].astype(hs.dtype)
        return jnp.einsum('sef,efd->sd', act, w_down)

    return lax.map(per_sequence, (h, combine))


def setup_inputs(seed: int = 0) -> dict:
    key = jax.random.key(seed)
    ks = jax.random.split(key, 16)
    nrm = jax.random.normal
    return {
        "x": nrm(ks[0], (BATCH, SEQ, D_MODEL), F32),
        "norm_mix_g": 1.0 + 0.02 * nrm(ks[1], (DEPTH, D_MODEL), F32),
        "w_in": nrm(ks[2], (DEPTH, D_MODEL, IN_COLS), F32) * D_MODEL ** -0.5,
        "b_forget": 3.0 + 0.5 * nrm(ks[3], (DEPTH, N_FOX_HEADS), F32),
        "fox_out_g": 1.0 + 0.02 * nrm(ks[4], (DEPTH, FOX_WIDTH), F32),
        "moba_out_g": 1.0 + 0.02 * nrm(ks[5], (DEPTH, MOBA_WIDTH), F32),
        "w_out": nrm(ks[6], (DEPTH, MIX_WIDTH, D_MODEL), F32) * MIX_WIDTH ** -0.5,
        "norm_ffn_g": 1.0 + 0.02 * nrm(ks[7], (DEPTH, D_MODEL), F32),
        "w_router_group": nrm(ks[8], (DEPTH, D_MODEL, N_GROUPS), F32) * D_MODEL ** -0.5,
        "b_router_group": 0.01 * nrm(ks[9], (DEPTH, N_GROUPS), F32),
        "w_router_expert": nrm(ks[10], (DEPTH, D_MODEL, N_GROUPS, EXPERTS_PER_GROUP), F32) * D_MODEL ** -0.5,
        "b_router_expert": 0.01 * nrm(ks[11], (DEPTH, N_GROUPS, EXPERTS_PER_GROUP), F32),
        "w_gate": nrm(ks[12], (DEPTH, N_EXPERTS, D_MODEL, D_EXPERT), F32) * D_MODEL ** -0.5,
        "w_up": nrm(ks[13], (DEPTH, N_EXPERTS, D_MODEL, D_EXPERT), F32) * D_MODEL ** -0.5,
        "w_down": nrm(ks[14], (DEPTH, N_EXPERTS, D_EXPERT, D_MODEL), F32) * D_EXPERT ** -0.5,
        "norm_final_g": 1.0 + 0.02 * nrm(ks[15], (D_MODEL,), F32),
    }


def reference(x, norm_mix_g, w_in, b_forget, fox_out_g, moba_out_g, w_out, norm_ffn_g,
              w_router_group, b_router_group, w_router_expert, b_router_expert,
              w_gate, w_up, w_down, norm_final_g):
    splits = [FOX_WIDTH, 2 * FOX_WIDTH, 3 * FOX_WIDTH, 3 * FOX_WIDTH + N_FOX_HEADS,
              3 * FOX_WIDTH + N_FOX_HEADS + MOBA_WIDTH,
              3 * FOX_WIDTH + N_FOX_HEADS + 2 * MOBA_WIDTH]
    for l in range(DEPTH):
        h = rms_norm(x, norm_mix_g[l])
        proj = jnp.einsum('bsd,dc->bsc', h, w_in[l])
        fq, fk, fv, f_logit, mq, mk, mv = jnp.split(proj, splits, axis=-1)
        log_f = jax.nn.log_sigmoid(f_logit.astype(F32) + b_forget[l].astype(F32)).transpose(0, 2, 1)
        fox = forgetting_attention(to_heads(fq, N_FOX_HEADS), to_heads(fk, N_FOX_HEADS),
                                   to_heads(fv, N_FOX_HEADS), log_f)
        moba = moba_attention(partial_rotary(to_heads(mq, N_MOBA_HEADS)),
                              partial_rotary(to_heads(mk, N_MOBA_HEADS)),
                              to_heads(mv, N_MOBA_HEADS))
        mixed = jnp.concatenate([rms_norm(from_heads(fox), fox_out_g[l]),
                                 rms_norm(from_heads(moba), moba_out_g[l])], axis=-1)
        x = x + jnp.einsum('bsc,cd->bsd', mixed, w_out[l])
        h = rms_norm(x, norm_ffn_g[l])
        x = x + hierarchical_moe(h, w_router_group[l], b_router_group[l], w_router_expert[l],
                                 b_router_expert[l], w_gate[l], w_up[l], w_down[l])
    return rms_norm(x, norm_final_g)
```

```cpp
#include <hip/hip_runtime.h>
#include <cstdio>
#include <cstdint>
#include <cmath>

constexpr int BATCH = 8, SEQ = 4096, DM = 1024, T = BATCH * SEQ;
constexpr int HD = 64, NH = 8;
constexpr int NQKV = 3072;
constexpr int INC = 3080;
constexpr int NBLK = 16, MBLK = 256;
constexpr int NEXP = 32, NGRP = 4, EPG = 8, DEXP = 256;
constexpr float EPS = 1e-6f;
constexpr float C2 = 0.125f * 1.4426950408889634f;
constexpr float LOG2E = 1.4426950408889634f;

typedef _Float16 half_t;
typedef _Float16 h8 __attribute__((ext_vector_type(8)));
typedef float f32x4 __attribute__((ext_vector_type(4)));

constexpr size_t MiB = 1u << 20;
constexpr size_t WS_CTL = 0;
constexpr size_t WS_QKV = 64 * MiB;
constexpr size_t WS_O = 320 * MiB;
constexpr size_t WS_MISC = 384 * MiB;
constexpr size_t WS_RSTD1 = WS_MISC;
constexpr size_t WS_LOGF = WS_MISC + 1 * MiB;
constexpr size_t WS_CB = WS_MISC + 2 * MiB;
constexpr size_t WS_KSUM = WS_MISC + 3 * MiB;
constexpr size_t WS_SSQ = WS_MISC + 4 * MiB;
constexpr size_t WS_TOK = WS_MISC + 6 * MiB;
constexpr size_t WS_ROPE = WS_MISC + 8 * MiB;
constexpr size_t WS_END = 416 * MiB;

struct TokInfo { int e1, e2; float w1, w2, rstd2; int pad0, pad1, pad2; };

__device__ __forceinline__ float wave_sum(float v) {
#pragma unroll
    for (int o = 1; o < 64; o <<= 1) v += __shfl_xor(v, o);
    return v;
}
__device__ __forceinline__ float wave_max(float v) {
#pragma unroll
    for (int o = 1; o < 64; o <<= 1) v = fmaxf(v, __shfl_xor(v, o));
    return v;
}

struct RopeArgs { double inv_freq[8]; };
__global__ void nk_rope(float2* rope, RopeArgs ra) {
    const int idx = blockIdx.x * blockDim.x + threadIdx.x;
    if (idx >= SEQ * 8) return;
    const int s = idx >> 3, i = idx & 7;
    const double ang = (double)s * ra.inv_freq[i];
    const double TWO_PI = 6.283185307179586476925286766559;
    const double n = rint(ang / TWO_PI);
    const float r = (float)(ang - n * TWO_PI);
    rope[idx] = make_float2(cosf(r), sinf(r));
}

__global__ void __launch_bounds__(256) nk_rowstats(const float* __restrict__ x, const float* __restrict__ g, const float* __restrict__ w_in,
                                                   const float* __restrict__ b_forget, float* rstd1, float* logf) {
    const int row = blockIdx.x, tid = threadIdx.x, lane = tid & 63, wid = tid >> 6;
    __shared__ float red[4][9];
    const float* xr = x + (size_t)row * DM;
    float ss = 0.f, d[8] = {0.f, 0.f, 0.f, 0.f, 0.f, 0.f, 0.f, 0.f};
    for (int k = tid; k < DM; k += 256) {
        const float v = xr[k]; ss += v * v;
        const float vg = v * g[k];
        const float* w = w_in + (size_t)k * INC + 1536;
#pragma unroll
        for (int j = 0; j < 8; ++j) d[j] += vg * w[j];
    }
    ss = wave_sum(ss);
#pragma unroll
    for (int j = 0; j < 8; ++j) d[j] = wave_sum(d[j]);
    if (lane == 0) { red[wid][8] = ss;
#pragma unroll
        for (int j = 0; j < 8; ++j) red[wid][j] = d[j]; }
    __syncthreads();
    if (tid < 8) {
        const float s = red[0][8] + red[1][8] + red[2][8] + red[3][8];
        const float rs = 1.0f / sqrtf(s * (1.0f / DM) + EPS);
        if (tid == 0) rstd1[row] = rs;
        const float z = (red[0][tid] + red[1][tid] + red[2][tid] + red[3][tid]) * rs + b_forget[tid];
        const float lf = fminf(z, 0.f) - log1pf(expf(-fabsf(z)));
        const int b = row / SEQ, s_ = row % SEQ;
        logf[((size_t)b * 8 + tid) * SEQ + s_] = lf;
    }
}

__global__ void nk_cumsum(const float* logf, float* cb) {
    const int i = blockIdx.x * blockDim.x + threadIdx.x;
    if (i >= BATCH * 8) return;
    const float* p = logf + (size_t)i * SEQ; float* o = cb + (size_t)i * SEQ;
    float c = 0.f;
    for (int s = 0; s < SEQ; ++s) { c += p[s]; o[s] = c * LOG2E; }
}

template <class FA, class FB, class FS>
__global__ void __launch_bounds__(256) nk_gemm(int K, FA fa, FB fb, FS fs) {
    __shared__ float As[16][65];
    __shared__ float Bs[16][65];
    const int tid = threadIdx.x, tx = tid & 15, ty = tid >> 4;
    const int m0 = blockIdx.y * 64, n0 = blockIdx.x * 64;
    float acc[4][4];
#pragma unroll
    for (int i = 0; i < 4; ++i)
#pragma unroll
        for (int j = 0; j < 4; ++j) acc[i][j] = 0.f;
    for (int k0 = 0; k0 < K; k0 += 16) {
#pragma unroll
        for (int it = 0; it < 4; ++it) { const int i = tid + it * 256; const int kk = i & 15, mm = i >> 4; As[kk][mm] = fa(m0 + mm, k0 + kk); }
#pragma unroll
        for (int it = 0; it < 4; ++it) { const int i = tid + it * 256; const int nn = i & 63, kk = i >> 6; Bs[kk][nn] = fb(k0 + kk, n0 + nn); }
        __syncthreads();
#pragma unroll
        for (int kk = 0; kk < 16; ++kk) {
            float a[4], b[4];
#pragma unroll
            for (int i = 0; i < 4; ++i) a[i] = As[kk][ty * 4 + i];
#pragma unroll
            for (int j = 0; j < 4; ++j) b[j] = Bs[kk][tx * 4 + j];
#pragma unroll
            for (int i = 0; i < 4; ++i)
#pragma unroll
                for (int j = 0; j < 4; ++j) acc[i][j] += a[i] * b[j];
        }
        __syncthreads();
    }
#pragma unroll
    for (int i = 0; i < 4; ++i)
#pragma unroll
        for (int j = 0; j < 4; ++j) fs(m0 + ty * 4 + i, n0 + tx * 4 + j, acc[i][j]);
}

struct InA { const float* x; const float* g; __device__ float operator()(int m, int k) const { return x[(size_t)m * DM + k] * g[k]; } };
struct InB { const float* w; __device__ float operator()(int k, int n) const { return w[(size_t)k * INC + (n < 1536 ? n : n + 8)]; } };
struct InS { const float* rstd1; half_t* qkv;
    __device__ void operator()(int m, int n, float v) const {
        v *= rstd1[m]; const int blk = n >> 9; if (blk == 0 || blk == 3) v *= C2;
        qkv[(size_t)m * NQKV + n] = (half_t)v; } };

__global__ void nk_rotary(half_t* qkv, const float2* rope) {
    const size_t idx = (size_t)blockIdx.x * blockDim.x + threadIdx.x;
    if (idx >= (size_t)T * 128) return;
    const int i = idx & 7, h = (idx >> 3) & 7, which = (idx >> 6) & 1; const int row = (int)(idx >> 7);
    const int s = row % SEQ;
    half_t* p = qkv + (size_t)row * NQKV + 1536 + which * 512 + h * 64 + i;
    const float t1 = (float)p[0], t2 = (float)p[8];
    const float2 cs = rope[s * 8 + i];
    p[0] = (half_t)(t1 * cs.x - t2 * cs.y);
    p[8] = (half_t)(t2 * cs.x + t1 * cs.y);
}
__global__ void nk_ksum(const half_t* qkv, float* ksum) {
    const int bb = blockIdx.x;
    const int col = threadIdx.x + blockIdx.y * 256;
    const half_t* p = qkv + (size_t)bb * MBLK * NQKV + 2048 + col;
    float s = 0.f;
    for (int r = 0; r < MBLK; ++r) s += (float)p[(size_t)r * NQKV];
    ksum[(size_t)bb * 512 + col] = s;
}

template <bool FOX>
__global__ void __launch_bounds__(256) nk_attn(const half_t* __restrict__ qkv, const float* __restrict__ cb, const float* __restrict__ ksum,
                                               half_t* O, float* ssq) {
    const int lane = threadIdx.x & 63, wid = threadIdx.x >> 6;
    const int gw = blockIdx.x * 4 + wid;
    const int h = gw & 7, tok = gw >> 3;
    const int b = tok / SEQ, t = tok % SEQ;
    const int qoff = FOX ? 0 : 1536, koff = FOX ? 512 : 2048, voff = FOX ? 1024 : 2560;
    float q[64];
    {
        const h8* qp = (const h8*)(qkv + (size_t)tok * NQKV + qoff + h * 64);
#pragma unroll
        for (int c = 0; c < 8; ++c) { const h8 v = qp[c];
#pragma unroll
            for (int j = 0; j < 8; ++j) q[c * 8 + j] = (float)v[j]; }
    }
    unsigned selmask = 0; const int own = t / MBLK;
    float cbt = 0.f; const float* cbp = nullptr;
    if (FOX) { cbp = cb + ((size_t)b * 8 + h) * SEQ; cbt = cbp[t]; }
    else {
        float gate = -INFINITY;
        if (lane < own) { const float* kp = ksum + ((size_t)(b * 16 + lane)) * 512 + h * 64; float s = 0.f;
#pragma unroll
            for (int d = 0; d < 64; ++d) s += q[d] * kp[d];
            gate = s; }
        float gts[16];
#pragma unroll
        for (int n = 0; n < 16; ++n) gts[n] = __shfl(gate, n);
#pragma unroll
        for (int it = 0; it < 3; ++it) {
            float best = -INFINITY; int bi = -1;
#pragma unroll
            for (int n = 0; n < 16; ++n) { const bool ok = (n < own) && !((selmask >> n) & 1u) && (gts[n] > best); if (ok) { best = gts[n]; bi = n; } }
            if (bi >= 0) selmask |= 1u << bi;
        }
        selmask |= 1u << own;
    }
    float m = -INFINITY, l = 0.f; float o[64];
#pragma unroll
    for (int d = 0; d < 64; ++d) o[d] = 0.f;
    const int nchunk = t / 64 + 1;
    for (int c = 0; c < nchunk; ++c) {
        if (!FOX) { if (!((selmask >> (c >> 2)) & 1u)) continue; }
        const int s = c * 64 + lane;
        float sc = -INFINITY;
        if (s <= t) {
            const h8* kp = (const h8*)(qkv + ((size_t)b * SEQ + s) * NQKV + koff + h * 64); float a = 0.f;
#pragma unroll
            for (int cc = 0; cc < 8; ++cc) { const h8 v = kp[cc];
#pragma unroll
                for (int j = 0; j < 8; ++j) a += q[cc * 8 + j] * (float)v[j]; }
            sc = a; if (FOX) sc += cbt - cbp[s];
        }
        const float cm = wave_max(sc);
        const float mn = fmaxf(m, cm);
        const float f = exp2f(m - mn);
        const float p = exp2f(sc - mn);
        l = l * f + p;
        m = mn;
        if (s <= t) {
            const h8* vp = (const h8*)(qkv + ((size_t)b * SEQ + s) * NQKV + voff + h * 64);
#pragma unroll
            for (int cc = 0; cc < 8; ++cc) { const h8 v = vp[cc];
#pragma unroll
                for (int j = 0; j < 8; ++j) o[cc * 8 + j] = o[cc * 8 + j] * f + p * (float)v[j]; }
        } else {
#pragma unroll
            for (int d = 0; d < 64; ++d) o[d] *= f;
        }
    }
    l = wave_sum(l);
    const float il = 1.0f / l;
    float mine = 0.f;
#pragma unroll
    for (int d = 0; d < 64; ++d) { const float v = wave_sum(o[d]); if (lane == d) mine = v; }
    const half_t hv = (half_t)(mine * il);
    O[(size_t)tok * DM + (FOX ? 0 : 512) + h * 64 + lane] = hv;
    const float fv = (float)hv; const float sq = wave_sum(fv * fv);
    if (lane == 0) ssq[(size_t)tok * 16 + (FOX ? 0 : 8) + h] = sq;
}

struct OutA { const half_t* O; const float* ssq; const float* gf; const float* gm;
    __device__ float operator()(int m, int k) const {
        const float* sp = ssq + (size_t)m * 16 + (k < 512 ? 0 : 8);
        float s = 0.f;
#pragma unroll
        for (int j = 0; j < 8; ++j) s += sp[j];
        const float rs = 1.0f / sqrtf(s * (1.0f / 512.0f) + EPS);
        return (float)O[(size_t)m * DM + k] * rs * (k < 512 ? gf[k] : gm[k - 512]); } };
struct OutB { const float* w; __device__ float operator()(int k, int n) const { return w[(size_t)k * DM + n]; } };
struct OutS { const float* x; float* x2; __device__ void operator()(int m, int n, float v) const { x2[(size_t)m * DM + n] = x[(size_t)m * DM + n] + v; } };

__global__ void __launch_bounds__(256) nk_router(const float* __restrict__ x2, const float* __restrict__ g, const float* __restrict__ wrg, const float* __restrict__ brg,
                                                 const float* __restrict__ wre, const float* __restrict__ bre, TokInfo* tok) {
    const int row = blockIdx.x, tid = threadIdx.x, lane = tid & 63, wid = tid >> 6;
    __shared__ float hs[DM]; __shared__ float red[4]; __shared__ float lg[36];
    const float* xr = x2 + (size_t)row * DM;
    float ss = 0.f;
    for (int k = tid; k < DM; k += 256) { const float v = xr[k]; ss += v * v; hs[k] = v * g[k]; }
    ss = wave_sum(ss); if (lane == 0) red[wid] = ss;
    __syncthreads();
    const float rs = 1.0f / sqrtf((red[0] + red[1] + red[2] + red[3]) * (1.0f / DM) + EPS);
    if (tid < 36) {
        float s = 0.f;
        if (tid < 4) { for (int k = 0; k < DM; ++k) s += hs[k] * wrg[(size_t)k * 4 + tid]; s = s * rs + brg[tid]; }
        else { const int j = tid - 4; for (int k = 0; k < DM; ++k) s += hs[k] * wre[(size_t)k * 32 + j]; s = s * rs + bre[j]; }
        lg[tid] = s;
    }
    __syncthreads();
    if (tid == 0) {
        int gi = 0; float gm = lg[0];
        for (int j = 1; j < 4; ++j) if (lg[j] > gm) { gm = lg[j]; gi = j; }
        float gs = 0.f; for (int j = 0; j < 4; ++j) gs += expf(lg[j] - gm);
        const float gtop = 1.0f / gs;
        const float* el = lg + 4 + gi * 8;
        int i1 = 0; float m1 = el[0];
        for (int j = 1; j < 8; ++j) if (el[j] > m1) { m1 = el[j]; i1 = j; }
        int i2 = -1; float m2 = -INFINITY;
        for (int j = 0; j < 8; ++j) if (j != i1 && el[j] > m2) { m2 = el[j]; i2 = j; }
        const float e2 = expf(m2 - m1);
        const float w1 = gtop / (1.0f + e2), w2 = gtop * e2 / (1.0f + e2);
        TokInfo ti; ti.e1 = gi * 8 + i1; ti.e2 = gi * 8 + i2; ti.w1 = w1; ti.w2 = w2; ti.rstd2 = rs; ti.pad0 = ti.pad1 = ti.pad2 = 0;
        tok[row] = ti;
    }
}

__global__ void __launch_bounds__(256) nk_moe(const float* __restrict__ x2, const float* __restrict__ g, const TokInfo* __restrict__ tok,
                                              const float* __restrict__ wg, const float* __restrict__ wu, const float* __restrict__ wd,
                                              const float* __restrict__ gfin, float* out) {
    const int row = blockIdx.x, tid = threadIdx.x, lane = tid & 63, wid = tid >> 6;
    __shared__ float hs[DM]; __shared__ float act[DEXP]; __shared__ float red[4];
    const TokInfo ti = tok[row];
    const float* xr = x2 + (size_t)row * DM;
    float xv[4];
#pragma unroll
    for (int j = 0; j < 4; ++j) { const int k = tid + 256 * j; xv[j] = xr[k]; hs[k] = xv[j] * ti.rstd2 * g[k]; }
    __syncthreads();
    float y[4] = {0.f, 0.f, 0.f, 0.f};
    for (int sl = 0; sl < 2; ++sl) {
        const int e = sl == 0 ? ti.e1 : ti.e2; const float cw = sl == 0 ? ti.w1 : ti.w2;
        const float* pg = wg + (size_t)e * DM * DEXP + tid; const float* pu = wu + (size_t)e * DM * DEXP + tid;
        float a = 0.f, u = 0.f;
        for (int k = 0; k < DM; ++k) { const float hv = hs[k]; a += hv * pg[(size_t)k * DEXP]; u += hv * pu[(size_t)k * DEXP]; }
        const float sv = a / (1.0f + expf(-a));
        __syncthreads();
        act[tid] = sv * u * cw;
        __syncthreads();
        const float* pd = wd + (size_t)e * DEXP * DM;
        for (int f = 0; f < DEXP; ++f) { const float av = act[f];
#pragma unroll
            for (int j = 0; j < 4; ++j) y[j] += av * pd[(size_t)f * DM + tid + 256 * j]; }
    }
    float ss = 0.f;
#pragma unroll
    for (int j = 0; j < 4; ++j) { y[j] += xv[j]; ss += y[j] * y[j]; }
    ss = wave_sum(ss); if (lane == 0) red[wid] = ss;
    __syncthreads();
    const float rs = 1.0f / sqrtf((red[0] + red[1] + red[2] + red[3]) * (1.0f / DM) + EPS);
#pragma unroll
    for (int j = 0; j < 4; ++j) { const int k = tid + 256 * j; out[(size_t)row * DM + k] = y[j] * rs * gfin[k]; }
}


#define LAS __attribute__((address_space(3)))
#define GAS __attribute__((address_space(1)))
typedef unsigned u32x4 __attribute__((ext_vector_type(4)));
typedef unsigned u32x2 __attribute__((ext_vector_type(2)));
typedef float f32x2 __attribute__((ext_vector_type(2)));
typedef _Float16 h2v __attribute__((ext_vector_type(2)));
typedef float f32x16 __attribute__((ext_vector_type(16)));
typedef short s16x4 __attribute__((ext_vector_type(4)));
typedef int i32x4 __attribute__((ext_vector_type(4)));
typedef int i32x8 __attribute__((ext_vector_type(8)));

__device__ __forceinline__ unsigned pkh(float lo, float hi) { f32x2 v = {lo, hi}; h2v h = __builtin_convertvector(v, h2v); return __builtin_bit_cast(unsigned, h); }

constexpr size_t WS_W1T = 2 * MiB;
constexpr size_t WS_WOT = 8 * MiB;
constexpr size_t WS_WRT = 10 * MiB;
constexpr size_t WS_WGU = 11 * MiB;
constexpr size_t WS_WD = 43 * MiB;
constexpr size_t WS_H8 = 456 * MiB;
constexpr size_t WS_XH = 256 * MiB;
#ifndef MOBA_SPARSE
#define MOBA_SPARSE 0
#endif
constexpr size_t WS_ACT = MOBA_SPARSE ? 64 * MiB : 416 * MiB;
constexpr size_t WS_Y = 104 * MiB;
constexpr size_t WS_CNT = WS_MISC + 9 * MiB;
constexpr size_t WS_NRM = WS_MISC + 10 * MiB;
constexpr size_t WS_CNTQ = WS_MISC + 11 * MiB;
constexpr size_t WS_LQ = WS_XH;
constexpr size_t WS_PML = WS_XH + 16 * MiB;
constexpr size_t WS_PO = 416 * MiB;
constexpr size_t WS_END2 = 512 * MiB;
constexpr size_t WS_TRDY = WS_MISC + 12 * MiB;
constexpr size_t WS_PRDY = WS_MISC + 13 * MiB;
constexpr size_t WS_LTOK = WS_MISC + 16 * MiB;
constexpr size_t WS_LRS = WS_MISC + 20 * MiB;
constexpr size_t WS_LCW = WS_MISC + 24 * MiB;

constexpr int RING_BYTES = 131072;
constexpr int LDSX_OFF = RING_BYTES;
constexpr int LX_HIST = 64, LX_EBASE = 192, LX_TOFF = 512, LX_RTOK = 1024, LX_RRS = 1024 + 3072, LX_RCW = 1024 + 6144, LX_TEXP = 10240;
constexpr int LDS_BYTES = 147456;
constexpr int MAXU = 3;

namespace pg8 {
constexpr int BM = 256, BK = 64, HALF = 128, HTB = HALF * BK * 2, STAGE_BYTES = 8 * HTB;
__host__ __device__ __forceinline__ int lds_byte(int r, int c) { const int st = (r >> 4) * 2 + (c >> 5), rr = r & 15, cc = c & 31, ob = rr * 64 + cc * 2; return st * 1024 + (ob ^ (((ob >> 9) & 1) << 5)); }
__host__ __device__ __forceinline__ void stage_rc(int b, int& R, int& C) { const int st = b / 1024, sb = b % 1024, swz = sb ^ (((sb >> 9) & 1) << 5); R = (st >> 1) * 16 + swz / 64; C = (st & 1) * 32 + (swz % 64) / 2; }
__host__ __device__ __forceinline__ int perm32(int rho) { const int n = rho >> 4, i = rho & 15; return 8 * (i >> 2) + 4 * n + (i & 3); }
__host__ __device__ __forceinline__ int perm256(int p) { return 64 * ((p >> 5) & 3) + 16 * ((p >> 2) & 3) + 4 * ((p >> 4) & 1) + (p & 3); }

struct GUnit { const char* A; const char* B; int pm, pn, aux, par; };

template <class Epi, class Sched, bool ALIGN_EPI, bool F8 = false>
__device__ __forceinline__ void gemm_phase(LAS unsigned char* lds, const int K, const Sched& S, const Epi& E) {
    const int tid = threadIdx.x, wid = __builtin_amdgcn_readfirstlane(tid >> 6), lane = tid & 63, wr = wid >> 2, wc = wid & 3, fr = lane & 15, fq = lane >> 4;
    const int nt = K / BK;
    int Rr[2], Cc[2]; unsigned voffB[2];
#pragma unroll
    for (int i = 0; i < 2; ++i) { stage_rc(tid * 16 + i * 8192, Rr[i], Cc[i]); const int Rb = ((int)Epi::PERM == 2) ? perm256(Rr[i]) : Epi::PERM ? ((Rr[i] & ~31) + perm32(Rr[i] & 31)) : Rr[i]; voffB[i] = (unsigned)(Rb * K + Cc[i]) * 2u; }
    const size_t kstep = (size_t)(BK * 2);
    const size_t hstep = (size_t)(((int)Epi::PERM == 2) ? 8 : HALF) * K * 2;
    const unsigned ldsw = (unsigned)wid * 1024u;
    const int aoff = lds_byte(wr * 64 + fr, fq * 8), boff = lds_byte(wc * 32 + fr, fq * 8);
#define PG8_SA(b, h) (((b) * 2 + (h)) * HTB)
#define PG8_SB(b, h) ((4 + (b) * 2 + (h)) * HTB)
#define PG8_STAGE(bufoff, gbase, voff) do { _Pragma("unroll") for (int _i = 0; _i < 2; ++_i) \
        __builtin_amdgcn_global_load_lds((const unsigned*)((const char*)(gbase) + (voff)[_i]), (LAS unsigned*)(lds + (bufoff) + ldsw + _i * 8192), 16, 0, 0); } while (0)
#define PG8_LDA(dst, b, h) do { _Pragma("unroll") for (int m = 0; m < 4; ++m) _Pragma("unroll") for (int k = 0; k < 2; ++k) dst[m][k] = *(const LAS h8*)(lds + PG8_SA(b, h) + aoff + m * 2048 + k * 1024); } while (0)
#define PG8_LDB(dst, b, h) do { _Pragma("unroll") for (int n = 0; n < 2; ++n) _Pragma("unroll") for (int k = 0; k < 2; ++k) dst[n][k] = *(const LAS h8*)(lds + PG8_SB(b, h) + boff + n * 2048 + k * 1024); } while (0)
#define PG8_MMA(ai, bj, At, Bt) do { __builtin_amdgcn_s_setprio(1); _Pragma("unroll") for (int m = 0; m < 4; ++m) _Pragma("unroll") for (int n = 0; n < 2; ++n) { \
        if constexpr (F8) { const i32x8 b8_ = __builtin_shufflevector(__builtin_bit_cast(i32x4, Bt[n][0]), __builtin_bit_cast(i32x4, Bt[n][1]), 0, 1, 2, 3, 4, 5, 6, 7), \
                                        a8_ = __builtin_shufflevector(__builtin_bit_cast(i32x4, At[m][0]), __builtin_bit_cast(i32x4, At[m][1]), 0, 1, 2, 3, 4, 5, 6, 7); \
            asm volatile("v_mfma_scale_f32_16x16x128_f8f6f4 %0, %1, %2, %0, %3, %3 op_sel_hi:[0,0,0]" : "+v"(acc[ai][bj][m][n]) : "v"(b8_), "v"(a8_), "v"(sc127)); } \
        else { _Pragma("unroll") for (int k = 0; k < 2; ++k) acc[ai][bj][m][n] = __builtin_amdgcn_mfma_f32_16x16x32_f16(Bt[n][k], At[m][k], acc[ai][bj][m][n], 0, 0, 0); } } __builtin_amdgcn_s_setprio(0); } while (0)
#define PG8_WAIT_V(n) asm volatile("s_waitcnt vmcnt(" #n ")" ::: "memory")
#define PG8_WAIT_L(n) asm volatile("s_waitcnt lgkmcnt(" #n ")" ::: "memory")
#define PG8_BAR __builtin_amdgcn_s_barrier()
#define PG8_SCHED __builtin_amdgcn_sched_barrier(0)
#define PG8_OFFS(u, o) do { _Pragma("unroll") for (int _h = 0; _h < 2; ++_h) _Pragma("unroll") for (int _i = 0; _i < 2; ++_i) o[_h][_i] = S.aoff(u, _h * HALF + Rr[_i], Cc[_i], K); } while (0)
    GUnit cur, nxt; int ui = 0;
    if (!S.next(0, cur)) return;
    int sc127 = 127; asm volatile("" : "+v"(sc127));
    (void)sc127;
    f32x4 acc[2][2][4][2];
#pragma unroll
    for (int a = 0; a < 2; ++a)
#pragma unroll
        for (int b = 0; b < 2; ++b)
#pragma unroll
            for (int m = 0; m < 4; ++m)
#pragma unroll
                for (int n = 0; n < 2; ++n) acc[a][b][m][n] = (f32x4){0.f, 0.f, 0.f, 0.f};
    h8 At[4][2], B0[2][2], B1[2][2];
    unsigned oc[2][2], on[2][2];
    PG8_OFFS(cur, oc);
    const char* cA = cur.A; const char* cB = cur.B;
    PG8_STAGE(PG8_SB(0, 0), cB, voffB); PG8_STAGE(PG8_SB(0, 1), cB + hstep, voffB); PG8_STAGE(PG8_SA(0, 0), cA, oc[0]); PG8_STAGE(PG8_SA(0, 1), cA, oc[1]);
    if (wr == 1) PG8_BAR;
    PG8_WAIT_V(2); PG8_BAR;
    PG8_STAGE(PG8_SB(1, 0), cB + kstep, voffB); PG8_STAGE(PG8_SA(1, 0), cA + kstep, oc[0]); PG8_STAGE(PG8_SB(1, 1), cB + hstep + kstep, voffB);
    PG8_WAIT_V(6); PG8_BAR;
    for (;;) {
        bool has_next = false; const char* nA = cA; const char* nB = cB;
        if constexpr (Sched::DEFER) { S.prefetch(ui + 1);
#pragma unroll
            for (int h = 0; h < 2; ++h)
#pragma unroll
                for (int i = 0; i < 2; ++i) on[h][i] = oc[h][i]; }
        else { has_next = S.next(ui + 1, nxt); nA = has_next ? nxt.A : cA; nB = has_next ? nxt.B : cB;
            if constexpr (Sched::GATHER) { if (has_next) { PG8_OFFS(nxt, on); } else {
#pragma unroll
                for (int h = 0; h < 2; ++h)
#pragma unroll
                    for (int i = 0; i < 2; ++i) on[h][i] = oc[h][i]; } } }
        cur.par = ui & 1;
        if constexpr (Epi::HAS_MID) E.unit_begin(cur);
#pragma unroll 1
        for (int t = 0; t < nt; t += 2) {
            const bool last = (t == nt - 2);
            if constexpr (Sched::DEFER) { if (last) { has_next = S.next(ui + 1, nxt); nA = has_next ? nxt.A : cA; nB = has_next ? nxt.B : cB; } }
            if constexpr (Epi::HAS_MID) { if (t == (nt >> 1)) E.mid(acc, cur, wr, fr); }
            const char* a1 = cA + (size_t)(t + 1) * kstep;
            const char* a2 = last ? nA : cA + (size_t)(t + 2) * kstep; const char* b2 = last ? nB : cB + (size_t)(t + 2) * kstep;
            const char* a3 = a2 + kstep; const char* b3 = b2 + kstep;
            unsigned o2[2][2];
#pragma unroll
            for (int h = 0; h < 2; ++h)
#pragma unroll
                for (int i = 0; i < 2; ++i) { if constexpr (Sched::GATHER) o2[h][i] = last ? on[h][i] : oc[h][i]; else o2[h][i] = oc[h][i]; }
            PG8_LDB(B0, 0, 0); PG8_LDB(B1, 0, 1); PG8_SCHED; PG8_LDA(At, 0, 0); PG8_STAGE(PG8_SA(1, 1), a1, oc[1]);
            PG8_WAIT_V(8); PG8_WAIT_L(0); PG8_BAR; PG8_MMA(0, 0, At, B0); PG8_MMA(0, 1, At, B1); PG8_BAR; PG8_SCHED;
            PG8_LDA(At, 0, 1); PG8_STAGE(PG8_SB(0, 0), b2, voffB); PG8_STAGE(PG8_SB(0, 1), b2 + hstep, voffB); PG8_STAGE(PG8_SA(0, 0), a2, o2[0]);
            PG8_WAIT_V(8); PG8_WAIT_L(0); PG8_BAR; PG8_MMA(1, 0, At, B0); PG8_MMA(1, 1, At, B1); PG8_BAR; PG8_SCHED;
            PG8_LDB(B0, 1, 0); PG8_LDB(B1, 1, 1); PG8_SCHED; PG8_LDA(At, 1, 0); PG8_STAGE(PG8_SA(0, 1), a2, o2[1]);
            PG8_WAIT_V(8); PG8_WAIT_L(0); PG8_BAR; PG8_MMA(0, 0, At, B0); PG8_MMA(0, 1, At, B1); PG8_BAR; PG8_SCHED;
            PG8_LDA(At, 1, 1); PG8_STAGE(PG8_SB(1, 0), b3, voffB); PG8_STAGE(PG8_SB(1, 1), b3 + hstep, voffB); PG8_STAGE(PG8_SA(1, 0), a3, o2[0]);
            PG8_WAIT_V(8); PG8_WAIT_L(0); PG8_BAR; PG8_MMA(1, 0, At, B0); PG8_MMA(1, 1, At, B1); PG8_BAR; PG8_SCHED;
        }
        if constexpr (F8) asm volatile("s_nop 15\n\ts_nop 15" ::: "memory");
        if constexpr (ALIGN_EPI) { if (wr == 0) PG8_BAR; }
        E(acc, cur, wr, wc, fr, fq);
        if (!has_next) break;
#pragma unroll
        for (int a = 0; a < 2; ++a)
#pragma unroll
            for (int b = 0; b < 2; ++b)
#pragma unroll
                for (int m = 0; m < 4; ++m)
#pragma unroll
                    for (int n = 0; n < 2; ++n) acc[a][b][m][n] = (f32x4){0.f, 0.f, 0.f, 0.f};
        cur = nxt; cA = nA; cB = nB; ++ui;
        if constexpr (Sched::GATHER) {
#pragma unroll
        for (int h = 0; h < 2; ++h)
#pragma unroll
            for (int i = 0; i < 2; ++i) oc[h][i] = on[h][i]; }
        if constexpr (ALIGN_EPI) { if (wr == 1) PG8_BAR; }
    }
    PG8_WAIT_V(0);
    if constexpr (!ALIGN_EPI) { if (wr == 0) PG8_BAR; }
    PG8_BAR;
#undef PG8_SA
#undef PG8_SB
#undef PG8_STAGE
#undef PG8_LDA
#undef PG8_LDB
#undef PG8_MMA
#undef PG8_WAIT_V
#undef PG8_WAIT_L
#undef PG8_BAR
#undef PG8_SCHED
#undef PG8_OFFS
}

struct DenseOrder {
    static constexpr int NXCD = 8, WGM = 4; static constexpr bool GATHER = false, DEFER = false;
    const char* A; const char* Bt; int K, nM, nN, nwg, G, c;
    __device__ void init(const void* A_, const void* Bt_, int M, int N, int K_, int G_, int c_) { A = (const char*)A_; Bt = (const char*)Bt_; K = K_; nM = M / BM; nN = N / BM; nwg = nM * nN; G = G_; c = c_; }
    __device__ __forceinline__ bool next(int i, GUnit& u) const {
        const long L = (long)i * G + c; if (L >= nwg) return false;
        int wgid = (int)L; { const int q = nwg / NXCD, r = nwg % NXCD, xcd = wgid % NXCD, off = wgid / NXCD; wgid = (xcd < r ? xcd * (q + 1) : r * (q + 1) + (xcd - r) * q) + off; }
        const int nig = WGM * nN, gid = wgid / nig, fm = gid * WGM, gsz = (nM - fm) < WGM ? (nM - fm) : WGM;
        u.pm = fm + ((wgid % nig) % gsz); u.pn = (wgid % nig) / gsz; u.aux = 0;
        u.A = A + (size_t)u.pm * BM * K * 2; u.B = Bt + (size_t)u.pn * BM * K * 2; return true;
    }
    __device__ __forceinline__ unsigned aoff(const GUnit&, int row, int C, int K_) const { return (unsigned)(row * K_ + C) * 2u; }
};
}

namespace att {
constexpr int NW = 8, QBLK = 32, QB = QBLK * NW, KVBLK = 64;
constexpr int QP = NQKV, OP = DM, KP = HD;
__device__ __forceinline__ int crow(int r, int hi) { return (r & 3) + 8 * (r >> 2) + 4 * hi; }
#define SBAR() __builtin_amdgcn_sched_barrier(0)
__device__ __forceinline__ void cmask(f32x16& p0, f32x16& p1, int jb, int qrel, int hi) {
    const float NEG = -INFINITY; const int kb = 64 * jb + 4 * hi;
#pragma unroll
    for (int r = 0; r < 16; ++r) { const int kv = kb + (r & 3) + 8 * (r >> 2); if (kv > qrel) p0[r] = NEG; if (kv + 32 > qrel) p1[r] = NEG; }
}
constexpr int NSLOT = 3, SLOTB = 8192;
constexpr int LDS_K = 0, LDS_V = NSLOT * SLOTB, LDS_WS = 2 * NSLOT * SLOTB, LDS_OST = LDS_WS + NW * 64 * 4, LDS_CB = LDS_OST + NW * 4096, LDS_END = LDS_CB + SEQ * 4;
constexpr int LDS_CBH = 102400, LDS_KSH = LDS_CBH + SEQ * 4, LDS_HT_END = LDS_KSH + 15 * HD * 4;
constexpr float FLOOR2 = -1000.0f;
__device__ __forceinline__ void glds16(const void* gsrc, unsigned lds_dst) { unsigned keep;
    asm volatile("s_mov_b32 %0, m0\n\ts_mov_b32 m0, %2\n\ts_nop 0\n\tglobal_load_lds_dwordx4 %1, off\n\ts_mov_b32 m0, %0" : "=&s"(keep) : "v"(gsrc), "s"(lds_dst) : "memory"); }
__device__ __forceinline__ float max3f(float a, float b, float c) { float r; asm("v_max3_f32 %0, %1, %2, %3" : "=v"(r) : "v"(a), "v"(b), "v"(c)); return r; }
__device__ __forceinline__ float max2f(float a, float b) { float r; asm("v_max_f32_e32 %0, %1, %2" : "=v"(r) : "v"(a), "v"(b)); return r; }
__device__ __forceinline__ float fsub_s(float a, float b) { float r; asm("v_sub_f32_e32 %0, %1, %2" : "=v"(r) : "v"(a), "v"(b)); return r; }
#define WAIT_BAR(N) asm volatile("s_waitcnt vmcnt(" #N ") lgkmcnt(0)\n\ts_barrier" ::: "memory")
typedef LAS const char* lds_cptr;
typedef short v4i16_t __attribute__((ext_vector_type(4)));
__device__ __forceinline__ void kload8(h8* kf, lds_cptr kp) {
    kf[0] = *(const LAS h8*)(kp);        kf[1] = *(const LAS h8*)(kp + 512);
    kf[2] = *(const LAS h8*)(kp + 2048); kf[3] = *(const LAS h8*)(kp + 2560);
    kf[4] = *(const LAS h8*)(kp + 4096); kf[5] = *(const LAS h8*)(kp + 4608);
    kf[6] = *(const LAS h8*)(kp + 6144); kf[7] = *(const LAS h8*)(kp + 6656);
}
__device__ __forceinline__ void kload2(h8* kf, lds_cptr kp, int j) { kf[2 * j] = *(const LAS h8*)(kp + j * 2048); kf[2 * j + 1] = *(const LAS h8*)(kp + j * 2048 + 512); }
__device__ __forceinline__ s16x4 vtr(lds_cptr p) { return __builtin_bit_cast(s16x4, __builtin_amdgcn_ds_read_tr16_b64_v4i16((LAS v4i16_t*)p)); }
__device__ __forceinline__ float rowmax(const f32x16& p0, const f32x16& p1) {
    float a = max3f(p0[0], p0[1], p1[0]), b = max3f(p0[2], p0[3], p1[1]); a = max3f(a, p1[2], p1[3]);
#pragma unroll
    for (int r = 4; r < 16; r += 4) { a = max3f(a, p0[r], p0[r + 1]); b = max3f(b, p0[r + 2], p0[r + 3]); a = max3f(a, p1[r], p1[r + 1]); b = max3f(b, p1[r + 2], p1[r + 3]); }
    const float m = max2f(a, b);
    auto rr = __builtin_amdgcn_permlane32_swap(__float_as_uint(m), __float_as_uint(m), false, false);
    return max2f(__uint_as_float(rr[0]), __uint_as_float(rr[1]));
}
#define MF16(a, b, c) __builtin_amdgcn_mfma_f32_32x32x16_f16(a, b, c, 0, 0, 0)
__device__ __forceinline__ void pv(f32x16* o, int vb, h8 pa0, h8 pa1, h8 pa2, h8 pa3) {
#pragma unroll
    for (int d0 = 0; d0 < 2; ++d0) { s16x4 lo[4], hi[4];
#pragma unroll
        for (int ks = 0; ks < 4; ++ks) {
            asm volatile("ds_read_b64_tr_b16 %0,%1 offset:%c2" : "=&v"(lo[ks]) : "v"(vb), "i"(d0 * 4096 + ks * 1024) : "memory");
            asm volatile("ds_read_b64_tr_b16 %0,%1 offset:%c2" : "=&v"(hi[ks]) : "v"(vb), "i"(d0 * 4096 + ks * 1024 + 512) : "memory"); }
        asm volatile("s_waitcnt lgkmcnt(0)" ::: "memory"); SBAR();
#define PK(k) __builtin_bit_cast(h8, (__attribute__((ext_vector_type(8))) short){lo[k][0], lo[k][1], lo[k][2], lo[k][3], hi[k][0], hi[k][1], hi[k][2], hi[k][3]})
        o[d0] = MF16(pa0, PK(0), o[d0]);
        o[d0] = MF16(pa1, PK(1), o[d0]);
        o[d0] = MF16(pa2, PK(2), o[d0]);
        o[d0] = MF16(pa3, PK(3), o[d0]);
#undef PK
    }
}

__device__ __forceinline__ void head_tables(int b, int h, const float* ksum, char* shm, int tid) {
    const lds_cptr shm3 = (lds_cptr)shm; LAS float* ksh = (LAS float*)(shm3 + LDS_KSH);
    for (int i = tid; i < 15 * HD; i += NW * 64) ksh[i] = ksum[((size_t)(b * NBLK + (i >> 6))) * 512 + h * HD + (i & 63)];
    asm volatile("s_waitcnt vmcnt(0) lgkmcnt(0)\n\ts_barrier" ::: "memory");
}

struct AttNext { const half_t* K; const half_t* V; int b, h, qb, valid; };
template <bool FOX, int THRL, bool MERGE = false>
__device__ __forceinline__ int attn_unit(int b, int h, int qb, int NTU, const half_t* Q, const half_t* __restrict__ K, const half_t* __restrict__ V, half_t* O,
                                          const float* __restrict__ cbg, const float* __restrict__ ksum, const float* __restrict__ nrm, float* ssq, char* shm,
                                          int s0, bool pre, const AttNext nx, int* prdy, const half_t* parto = nullptr, const float* partml = nullptr) {
    int tid_ = threadIdx.x; asm volatile("" : "+v"(tid_));
    const int tid = tid_, lane = tid & 63, r32 = lane & 31, hi = lane >> 5; const int wid = __builtin_amdgcn_readfirstlane(tid >> 6);
    const long rowbase = (long)b * SEQ; const int q0 = qb * QB;
    const size_t hbase = ((size_t)b * NH + h) * SEQ * KP;
    const half_t* Qw = Q + hbase + (size_t)(q0 + wid * QBLK) * KP;
    const half_t* Kh = K + hbase; const half_t* Vh = V + hbase;
    const unsigned lds0 = (unsigned)(uintptr_t)shm;
    float* wsf = (float*)(shm + LDS_WS) + wid * 64;
    const int NT = (q0 + QB) / KVBLK;
    const half_t* ksrc = Kh + ((long)(NT - 1) * KVBLK + lane) * KP + wid * 8;
    const half_t* vsrc = Vh + ((long)(NT - 1) * KVBLK + 16 * (wid & 3) + (lane >> 2)) * KP + (wid >> 2) * 32 + (lane & 3) * 8;
    const unsigned kdst = lds0 + LDS_K + wid * 1024, vdst = lds0 + LDS_V + wid * 1024;
#define DMA_K(t, slot) glds16(ksrc - (long)(t) * KVBLK * KP, (unsigned)__builtin_amdgcn_readfirstlane(kdst + (slot)))
#define DMA_V(t, slot) glds16(vsrc - (long)(t) * KVBLK * KP, (unsigned)__builtin_amdgcn_readfirstlane(vdst + (slot)))
    const int vb0 = (int)(lds0 + LDS_V) + ((lane >> 4) & 1) * 32 + (lane & 3) * 8 + (4 * hi + ((lane & 15) >> 2)) * 64;
    const char* Kbase = shm + LDS_K; h8 kf[8];
    const lds_cptr shm3 = (lds_cptr)shm; const lds_cptr kp0 = shm3 + LDS_K + hi * 1024 + r32 * 16; const lds_cptr vp0 = shm3 + LDS_V + ((lane >> 4) & 1) * 32 + (lane & 3) * 8 + (4 * hi + ((lane & 15) >> 2)) * 64;
    const LAS float* cbl = (const LAS float*)(shm3 + LDS_CB);
    float cref = 0.f;
    const int s1 = (s0 == (NSLOT - 1) * SLOTB) ? 0 : s0 + SLOTB, s2 = (s1 == (NSLOT - 1) * SLOTB) ? 0 : s1 + SLOTB;
    if (!pre) { DMA_K(0, s0); DMA_V(0, s0); DMA_K(1, s1); }
    h8 qr[4];
#pragma unroll
    for (int d0 = 0; d0 < 4; ++d0) qr[d0] = *reinterpret_cast<const h8*>(&Qw[(long)r32 * KP + d0 * 16 + hi * 8]);
    unsigned selmask = 0xffffffffu;
    if constexpr (FOX) {
        const float* cbp = cbg + ((size_t)b * NH + h) * SEQ;
        cref = cbp[q0 + QB - 1];
        for (int i = tid * 4; i < q0 + QB; i += NW * 64 * 4) *(LAS f32x4*)(shm3 + LDS_CB + (size_t)i * 4) = *(const f32x4*)(cbp + i);
        const half_t* Kw = Kh + ((long)q0 + wid * QBLK + r32) * KP + hi * 8;
        float qq = 0.f, qk = 0.f;
#pragma unroll
        for (int d0 = 0; d0 < 4; ++d0) { const h8 kv = *reinterpret_cast<const h8*>(Kw + d0 * 16);
#pragma unroll
            for (int j = 0; j < 8; ++j) { const float qf = (float)qr[d0][j]; qq += qf * qf; qk += qf * (float)kv[j]; } }
        qq += __shfl_xor(qq, 32); qk += __shfl_xor(qk, 32);
        const float* nr = nrm + ((size_t)b * NH + h) * 4;
        float need = 36.01f + sqrtf(qq) * sqrtf(nr[2] + nr[3]) * 1.001f - qk + cbp[q0 + wid * QBLK + r32];
#pragma unroll
        for (int o = 1; o < 32; o <<= 1) need = __builtin_fmaxf(need, __shfl_xor(need, o));
        if (lane == 0) wsf[63] = need;
    } else {
      if constexpr (MERGE) { selmask = 1u << qb; } else {
        float v0 = -INFINITY, v1 = -INFINITY, v2 = -INFINITY; int i0 = 31, i1 = 31, i2 = 31;
#pragma unroll 1
        for (int n = 0; n < qb; ++n) {
            const LAS float* kp = (const LAS float*)(shm3 + LDS_KSH) + n * HD + hi * 8; float s = 0.f;
#pragma unroll
            for (int d0 = 0; d0 < 4; ++d0) { const f32x4 k0 = *(const LAS f32x4*)(kp + d0 * 16), k1 = *(const LAS f32x4*)(kp + d0 * 16 + 4);
                s += (float)qr[d0][0] * k0[0] + (float)qr[d0][1] * k0[1] + (float)qr[d0][2] * k0[2] + (float)qr[d0][3] * k0[3] + (float)qr[d0][4] * k1[0] + (float)qr[d0][5] * k1[1] + (float)qr[d0][6] * k1[2] + (float)qr[d0][7] * k1[3]; }
            s += __shfl_xor(s, 32);
            const bool g0 = s > v0, g1 = s > v1, g2 = s > v2;
            v2 = g1 ? v1 : (g2 ? s : v2); i2 = g1 ? i1 : (g2 ? n : i2);
            v1 = g0 ? v0 : (g1 ? s : v1); i1 = g0 ? i0 : (g1 ? n : i1);
            v0 = g0 ? s : v0; i0 = g0 ? n : i0;
        }
        selmask = ((1u << i0) | (1u << i1) | (1u << i2) | (1u << qb)) & 0xffffu;
      }
    }
    float mhat = 0.f, l_reg = 0.f; f32x16 o[2]; o[0] = f32x16{}; o[1] = f32x16{};
    const int qrel = wid * QBLK + r32;
    bool resc = false;
#define RESC() do { if (resc) { asm volatile("s_waitcnt lgkmcnt(0)" ::: "memory"); \
        _Pragma("unroll") for (int d_ = 0; d_ < 2; ++d_) _Pragma("unroll") for (int r = 0; r < 16; ++r) o[d_][r] *= wsf[crow(r, hi)]; } } while (0)
    f32x16 pA0, pA1, pB0, pB1;
    int sl_prev = s0, sl_cur = s0, sl_next = s1;
#define ROT() do { sl_prev = sl_cur; sl_cur = sl_next; sl_next = (sl_next == (NSLOT - 1) * SLOTB) ? 0 : sl_next + SLOTB; } while (0)
#define CINIT(P0, P1, i) do { const int kt_ = NT - 1 - (i); \
        if constexpr (FOX) { const LAS float* cp_ = cbl + kt_ * KVBLK + 4 * hi; \
            _Pragma("unroll") for (int j_ = 0; j_ < 4; ++j_) { const f32x4 a_ = *(const LAS f32x4*)(cp_ + 8 * j_), b_ = *(const LAS f32x4*)(cp_ + 32 + 8 * j_); \
                _Pragma("unroll") for (int e_ = 0; e_ < 4; ++e_) { P0[4 * j_ + e_] = (cref - mhat) - a_[e_]; P1[4 * j_ + e_] = (cref - mhat) - b_[e_]; } } } \
        else { const float c_ = ((selmask >> (kt_ >> 2)) & 1u) ? -mhat : -INFINITY; \
            _Pragma("unroll") for (int r_ = 0; r_ < 16; ++r_) { P0[r_] = c_; P1[r_] = c_; } } } while (0)
#define CINIT_G(P0, P1, i, g) do { const int kt_ = NT - 1 - (i); \
        if constexpr (FOX) { const LAS float* cp_ = cbl + kt_ * KVBLK + 4 * hi + 8 * ((g) >> 1) + 2 * ((g) & 1); \
            const f32x2 a_ = *(const LAS f32x2*)(cp_), b_ = *(const LAS f32x2*)(cp_ + 32); \
            const float cm_ = cref - mhat; P0[2 * (g)] = cm_ - a_[0]; P0[2 * (g) + 1] = cm_ - a_[1]; P1[2 * (g)] = cm_ - b_[0]; P1[2 * (g) + 1] = cm_ - b_[1]; } \
        else { const float c_ = ((selmask >> (kt_ >> 2)) & 1u) ? -mhat : -INFINITY; P0[2 * (g)] = c_; P0[2 * (g) + 1] = c_; P1[2 * (g)] = c_; P1[2 * (g) + 1] = c_; } } while (0)
    DMA_K(2, s2);
    WAIT_BAR(3);
    if constexpr (FOX) {
        const LAS float* wsa = (const LAS float*)(shm3 + LDS_WS); float X = wsa[63];
#pragma unroll
        for (int w = 1; w < NW; ++w) X = __builtin_fmaxf(X, wsa[w * 64 + 63]);
        const bool skip = (lane < 4 * qb) && (cbl[KVBLK * lane + KVBLK - 1] >= X);
        const int ns = __builtin_popcountll(__ballot(skip));
        NTU = NT - ns; NTU += NTU & 1;
        NTU = __builtin_amdgcn_readfirstlane(NTU);
    }
    CINIT(pA0, pA1, 0);
    {
        const char* kb = Kbase + s0 + hi * 1024 + r32 * 16;
#pragma unroll
        for (int d0 = 0; d0 < 4; ++d0) { const h8 b0 = *reinterpret_cast<const h8*>(kb + d0 * 2048); const h8 b1 = *reinterpret_cast<const h8*>(kb + d0 * 2048 + 512);
            pA0 = MF16(b0, qr[d0], pA0); pA1 = MF16(b1, qr[d0], pA1); }
    }
    asm volatile("s_nop 15\n\ts_nop 7" : "+v"(pA0), "+v"(pA1));
    cmask(pA0, pA1, 3, qrel, hi);
    { const float rm = rowmax(pA0, pA1); const float dl = __builtin_fmaxf(rm, FLOOR2); mhat = dl;
#pragma unroll
      for (int r = 0; r < 16; ++r) { pA0[r] = fsub_s(pA0[r], dl); pA1[r] = fsub_s(pA1[r], dl); }
#pragma unroll
      for (int r = 0; r < 16; ++r) pA0[r] = __builtin_amdgcn_exp2f(pA0[r]);
#pragma unroll
      for (int r = 0; r < 16; ++r) pA1[r] = __builtin_amdgcn_exp2f(pA1[r]); }
    WAIT_BAR(0);
    DMA_K(3, s0); DMA_V(1, s1);
    ROT();
    kload8(kf, kp0 + sl_cur);
    CINIT(pB0, pB1, 1);
    WAIT_BAR(2);
    s16x4 vlo[8], vhi[8]; u32x4 pw0, pw1, pw2, pw3;
#define PKW(P, B) pkh(P[B], P[B + 1])
#define PAF(k) __builtin_bit_cast(h8, pw##k)
#define VFR(i) __builtin_bit_cast(h8, (__attribute__((ext_vector_type(8))) short){vlo[i][0], vlo[i][1], vlo[i][2], vlo[i][3], vhi[i][0], vhi[i][1], vhi[i][2], vhi[i][3]})
#define PIN(x) asm volatile("" : "+v"(x))
#define MX3(a, b, c) __builtin_fmaxf(__builtin_fmaxf((a), (b)), (c))
#define GAPA(MF, A0, A1, A2, A3, W0, W1, PW) do { MF; sacc += A0; sacc += A1; sacc += A2; sacc += A3; PIN(sacc); W0; W1; PIN(PW); SBAR(); } while (0)
#define EX(v) __builtin_amdgcn_exp2f(v)
#define GAPB(MF, X, B) do { MF; X[B] = EX(X[B]); X[B + 1] = EX(X[B + 1]); X[B + 2] = EX(X[B + 2]); X[B + 3] = EX(X[B + 3]); PIN(X); SBAR(); } while (0)
#define VRD(i) do { vlo[i] = vtr(vp_ + (((i) >> 2) * 4096 + ((i) & 3) * 1024)); vhi[i] = vtr(vp_ + (((i) >> 2) * 4096 + ((i) & 3) * 1024 + 512)); } while (0)
#define KRD(G, j) do { if (G) { kload2(kf, kp0 + sl_next, j); SBAR(); } } while (0)
#define STEP(C0, C1, P0, P1, t, GK, GV, GL, MASKED) do { SBAR(); \
    const lds_cptr vp_ = vp0 + sl_prev; \
    VRD(0); SBAR(); float sacc = (P0[0] + P0[1]); \
    GAPA(C0 = MF16(kf[0], qr[0], C0), P0[2], P0[3], P0[4], P0[5],     pw0[0] = PKW(P0, 0), pw0[1] = PKW(P0, 2), pw0); \
    VRD(4); SBAR(); GAPA(C1 = MF16(kf[1], qr[0], C1), P0[6], P0[7], P0[8], P0[9],     pw0[2] = PKW(P0, 4), pw0[3] = PKW(P0, 6), pw0); \
    VRD(1); SBAR(); GAPA(C0 = MF16(kf[2], qr[1], C0),   P0[10], P0[11], P0[12], P0[13], pw1[0] = PKW(P0, 8), pw1[1] = PKW(P0, 10), pw1); \
    VRD(5); SBAR(); GAPA(C1 = MF16(kf[3], qr[1], C1),   P0[14], P0[15], P1[0], P1[1],   pw1[2] = PKW(P0, 12), pw1[3] = PKW(P0, 14), pw1); \
    VRD(2); SBAR(); GAPA(C0 = MF16(kf[4], qr[2], C0),   P1[2], P1[3], P1[4], P1[5],     pw2[0] = PKW(P1, 0), pw2[1] = PKW(P1, 2), pw2); \
    VRD(6); SBAR(); GAPA(C1 = MF16(kf[5], qr[2], C1),   P1[6], P1[7], P1[8], P1[9],     pw2[2] = PKW(P1, 4), pw2[3] = PKW(P1, 6), pw2); \
    VRD(3); SBAR(); GAPA(C0 = MF16(kf[6], qr[3], C0),   P1[10], P1[11], P1[12], P1[13], pw3[0] = PKW(P1, 8), pw3[1] = PKW(P1, 10), pw3); \
    VRD(7); SBAR(); GAPA(C1 = MF16(kf[7], qr[3], C1),   P1[14], P1[15], 0.f, 0.f,       pw3[2] = PKW(P1, 12), pw3[3] = PKW(P1, 14), pw3); \
    l_reg += sacc; \
    if (GK) { DMA_K((t) + 3, sl_cur); } if (GV) { DMA_V((t) + 1, sl_next); } \
    if (MASKED) { if ((t) < 4) cmask(C0, C1, 3 - (t), qrel, hi); } \
    { float a = MX3(C0[0], C0[1], C1[0]), b = MX3(C0[2], C0[3], C1[1]); a = MX3(a, C1[2], C1[3]); \
      _Pragma("unroll") for (int r = 4; r < 16; r += 4) { a = MX3(a, C0[r], C0[r + 1]); b = MX3(b, C0[r + 2], C0[r + 3]); a = MX3(a, C1[r], C1[r + 1]); b = MX3(b, C1[r + 2], C1[r + 3]); } \
      float rm = __builtin_fmaxf(a, b); { auto rr = __builtin_amdgcn_permlane32_swap(__float_as_uint(rm), __float_as_uint(rm), false, false); rm = __builtin_fmaxf(__uint_as_float(rr[0]), __uint_as_float(rr[1])); } \
      resc = false; \
      if (__builtin_expect(__any(rm > (float)THRL), 0)) { const float dl = __builtin_fmaxf(rm, 0.f); mhat += dl; \
        _Pragma("unroll") for (int r = 0; r < 16; ++r) { C0[r] -= dl; C1[r] -= dl; } \
        const float f = __builtin_amdgcn_exp2f(-dl); l_reg *= f; if (hi == 0) wsf[r32] = f; resc = true; } } \
    SBAR(); \
    GAPB(o[0] = MF16(PAF(0), VFR(0), o[0]), C0, 0); if (GL) { CINIT_G(P0, P1, (t) + 1, 0); } \
    GAPB(o[1] = MF16(PAF(0), VFR(4), o[1]), C0, 4); if (GL) { CINIT_G(P0, P1, (t) + 1, 1); } \
    KRD(GL, 0); GAPB(o[0] = MF16(PAF(1), VFR(1), o[0]), C0, 8); if (GL) { CINIT_G(P0, P1, (t) + 1, 2); } \
    KRD(GL, 1); GAPB(o[1] = MF16(PAF(1), VFR(5), o[1]), C0, 12); if (GL) { CINIT_G(P0, P1, (t) + 1, 3); } \
    KRD(GL, 2); GAPB(o[0] = MF16(PAF(2), VFR(2), o[0]), C1, 0); if (GL) { CINIT_G(P0, P1, (t) + 1, 4); } \
    KRD(GL, 3); GAPB(o[1] = MF16(PAF(2), VFR(6), o[1]), C1, 4); if (GL) { CINIT_G(P0, P1, (t) + 1, 5); } \
    GAPB(o[0] = MF16(PAF(3), VFR(3), o[0]), C1, 8); if (GL) { CINIT_G(P0, P1, (t) + 1, 6); } \
    GAPB(o[1] = MF16(PAF(3), VFR(7), o[1]), C1, 12); if (GL) { CINIT_G(P0, P1, (t) + 1, 7); } \
    } while (0)
#define ENDW(tt) do { if ((tt) + 3 < NTU) { WAIT_BAR(2); } else if ((tt) + 2 < NTU) { WAIT_BAR(1); } else { WAIT_BAR(0); } } while (0)
    int t = 1;
    for (; t < 5 && t + 1 < NTU; t += 2) {
        STEP(pB0, pB1, pA0, pA1, t, (t + 3 < NTU), (t + 1 < NTU), (t + 1 < NTU), true);         ENDW(t);     RESC(); ROT();
        STEP(pA0, pA1, pB0, pB1, t + 1, (t + 4 < NTU), (t + 2 < NTU), (t + 2 < NTU), true);     ENDW(t + 1); RESC(); ROT();
    }
    for (; t + 5 < NTU; t += 2) {
        STEP(pB0, pB1, pA0, pA1, t, true, true, true, false);     WAIT_BAR(2); RESC(); ROT();
        STEP(pA0, pA1, pB0, pB1, t + 1, true, true, true, false); WAIT_BAR(2); RESC(); ROT();
    }
    for (; t + 1 < NTU; t += 2) {
        STEP(pB0, pB1, pA0, pA1, t, (t + 3 < NTU), (t + 1 < NTU), (t + 1 < NTU), false);         ENDW(t);     RESC(); ROT();
        STEP(pA0, pA1, pB0, pB1, t + 1, (t + 4 < NTU), (t + 2 < NTU), (t + 2 < NTU), false);     ENDW(t + 1); RESC(); ROT();
    }
    const int s0_next = sl_next;
    if (nx.valid) { const int nNT = 4 * nx.qb + 4;
        const size_t nhb = ((size_t)nx.b * NH + nx.h) * SEQ * KP;
        const half_t* nks = nx.K + nhb + ((long)(nNT - 1) * KVBLK + lane) * KP + wid * 8;
        const half_t* nvs = nx.V + nhb + ((long)(nNT - 1) * KVBLK + 16 * (wid & 3) + (lane >> 2)) * KP + (wid >> 2) * 32 + (lane & 3) * 8;
        glds16(nks, (unsigned)__builtin_amdgcn_readfirstlane(kdst + sl_next)); glds16(nvs, (unsigned)__builtin_amdgcn_readfirstlane(vdst + sl_next));
        glds16(nks - (long)KVBLK * KP, (unsigned)__builtin_amdgcn_readfirstlane(kdst + sl_prev)); }
    STEP(pB0, pB1, pA0, pA1, NTU - 1, false, false, false, true); RESC();
    { float sacc = pB0[0] + pB0[1];
#pragma unroll
      for (int r = 2; r < 16; ++r) sacc += pB0[r];
#pragma unroll
      for (int r = 0; r < 16; ++r) sacc += pB1[r];
      l_reg += sacc;
      pw0 = (u32x4){PKW(pB0, 0), PKW(pB0, 2), PKW(pB0, 4), PKW(pB0, 6)}; pw1 = (u32x4){PKW(pB0, 8), PKW(pB0, 10), PKW(pB0, 12), PKW(pB0, 14)};
      pw2 = (u32x4){PKW(pB1, 0), PKW(pB1, 2), PKW(pB1, 4), PKW(pB1, 6)}; pw3 = (u32x4){PKW(pB1, 8), PKW(pB1, 10), PKW(pB1, 12), PKW(pB1, 14)};
      SBAR(); pv(o, vb0 + sl_cur, PAF(0), PAF(1), PAF(2), PAF(3)); }
#undef PKW
#undef PAF
#undef VFR
#undef PIN
#undef MX3
#undef GAPA
#undef GAPB
#undef EX
#undef VRD
#undef KRD
#undef STEP
#undef ENDW
    { auto rr = __builtin_amdgcn_permlane32_swap(__float_as_uint(l_reg), __float_as_uint(l_reg), false, false); l_reg = __uint_as_float(rr[0]) + __uint_as_float(rr[1]); }
    int tide = threadIdx.x; asm volatile("" : "+v"(tide));
    const int lanee = tide & 63, r32e = lanee & 31, hie = lanee >> 5;
    float* wsfe = (float*)(shm + LDS_WS) + wid * 64;
    if (hie == 0) { wsfe[32 + r32e] = l_reg; if constexpr (MERGE) wsfe[r32e] = mhat; } asm volatile("s_waitcnt lgkmcnt(0)" ::: "memory");
    float rli[16];
#pragma unroll
    for (int r = 0; r < 16; ++r) rli[r] = __builtin_amdgcn_rcpf(wsfe[32 + crow(r, hie)]);
    const long grow0 = (long)b * SEQ + qb * QB + wid * QBLK;
    f32x2 pm[4][3]; h8 po[4][3]; const int nsel = qb < 3 ? qb : 3;
    if constexpr (MERGE) {
#pragma unroll
        for (int i = 0; i < 4; ++i) { const size_t pb = ((size_t)(grow0 + i * 8 + (lanee >> 3)) * NH + h) * 3;
#pragma unroll
            for (int k = 0; k < 3; ++k) { if (k < nsel) { pm[i][k] = *(const f32x2*)(partml + (pb + k) * 2); po[i][k] = *(const h8*)(parto + (pb + k) * HD + (lanee & 7) * 8); }
                                          else { pm[i][k] = (f32x2){-INFINITY, 0.f}; po[i][k] = h8{}; } } }
    }
    const __amdgpu_buffer_rsrc_t orsrc = __builtin_amdgcn_make_buffer_rsrc((void*)O, 0, 0x7fffffff, 0x00020000);
    { half_t* stg = (half_t*)(shm + LDS_OST) + wid * 2048;
#pragma unroll
      for (int r = 0; r < 16; ++r) { const int orow = crow(r, hie);
#pragma unroll
          for (int d0 = 0; d0 < 2; ++d0) stg[orow * 64 + d0 * 32 + r32e] = (half_t)(o[d0][r] * rli[r]); }
      asm volatile("s_waitcnt lgkmcnt(0)" ::: "memory");
#pragma unroll
      for (int i = 0; i < 4; ++i) { const int row = i * 8 + (lanee >> 3), ch = lanee & 7; u32x4 v = *(const u32x4*)(stg + row * 64 + ch * 8);
          if constexpr (MERGE) {
              const float m0 = wsfe[row], l0 = wsfe[32 + row]; float M = m0;
#pragma unroll
              for (int k = 0; k < 3; ++k) M = __builtin_fmaxf(M, pm[i][k][0]);
              const float w0 = l0 * __builtin_amdgcn_exp2f(m0 - M); float W = w0, wk[3];
#pragma unroll
              for (int k = 0; k < 3; ++k) { wk[k] = pm[i][k][1] * __builtin_amdgcn_exp2f(pm[i][k][0] - M); W += wk[k]; }
              const float iW = __builtin_amdgcn_rcpf(W); const h8 ov = __builtin_bit_cast(h8, v); float acc[8];
#pragma unroll
              for (int e = 0; e < 8; ++e) acc[e] = (float)ov[e] * w0;
#pragma unroll
              for (int k = 0; k < 3; ++k)
#pragma unroll
                  for (int e = 0; e < 8; ++e) acc[e] += (float)po[i][k][e] * wk[k];
              v.x = pkh(acc[0] * iW, acc[1] * iW); v.y = pkh(acc[2] * iW, acc[3] * iW); v.z = pkh(acc[4] * iW, acc[5] * iW); v.w = pkh(acc[6] * iW, acc[7] * iW);
          }
          __builtin_amdgcn_raw_buffer_store_b128(v, orsrc, (unsigned)(((grow0 + row) * OP + h * HD + ch * 8) * 2), 0, 16);
          const h8 hv = __builtin_bit_cast(h8, v); float sq = 0.f;
#pragma unroll
          for (int j = 0; j < 8; ++j) { const float f = (float)hv[j]; sq += f * f; }
          sq += __shfl_xor(sq, 1); sq += __shfl_xor(sq, 2); sq += __shfl_xor(sq, 4);
          if (ch == 0) __hip_atomic_store(ssq + (size_t)(grow0 + row) * 16 + h, sq, __ATOMIC_RELAXED, __HIP_MEMORY_SCOPE_AGENT); } }
    asm volatile("s_waitcnt vmcnt(0)" ::: "memory");
    if (lanee == 0) __hip_atomic_fetch_add(prdy + b * NBLK + qb, 1, __ATOMIC_RELAXED, __HIP_MEMORY_SCOPE_AGENT);
    asm volatile("s_waitcnt lgkmcnt(0)\n\ts_barrier" ::: "memory");
#undef DMA_K
#undef DMA_V
#undef RESC
#undef ROT
#undef CINIT
#undef CINIT_G
    return s0_next;
}
#undef SBAR
#undef WAIT_BAR
#undef MF16
}

namespace att {
#define SBAR() __builtin_amdgcn_sched_barrier(0)
#define MF16(a, b, c) __builtin_amdgcn_mfma_f32_32x32x16_f16(a, b, c, 0, 0, 0)
constexpr int BLK_K = 0, BLK_V = 32768, BLK_WS = 65536, BLK_OST = BLK_WS + NW * 512, BLK_END = BLK_OST + NW * 4096;
constexpr int LQCAP = 4096;

__device__ __forceinline__ void moba_gate(const half_t* __restrict__ QKV, const float* ksum, int* cntq, int* lq, int gt, int NGT, int lane) {
    for (int idx = gt; idx < BATCH * NH * SEQ; idx += NGT) {
        const int r = idx & 255, i = (idx >> 8) & 15, bh = idx >> 12, b = bh >> 3, h = bh & 7, t = i * 256 + r;
        if (i == 0) continue;
        const h8* qp = (const h8*)(QKV + ((size_t)b * SEQ + t) * NQKV + 1536 + h * HD);
        float q[64];
#pragma unroll
        for (int c = 0; c < 8; ++c) { const h8 v = qp[c];
#pragma unroll
            for (int e = 0; e < 8; ++e) q[c * 8 + e] = (float)v[e]; }
        float v0 = -INFINITY, v1 = -INFINITY, v2 = -INFINITY; int i0 = 31, i1 = 31, i2 = 31;
        float kvs[15];
#pragma unroll
        for (int n = 0; n < 15; ++n) kvs[n] = (n < i) ? ksum[((size_t)(b * NBLK + n)) * 512 + h * HD + lane] : 0.f;
#pragma unroll
        for (int n = 0; n < 15; ++n) { if (n < i) {
            float s = 0.f;
#pragma unroll
            for (int d = 0; d < 64; ++d) s += q[d] * __builtin_bit_cast(float, __builtin_amdgcn_readlane(__builtin_bit_cast(int, kvs[n]), d));
            const bool g0 = s > v0, g1 = s > v1, g2 = s > v2;
            v2 = g1 ? v1 : (g2 ? s : v2); i2 = g1 ? i1 : (g2 ? n : i2);
            v1 = g0 ? v0 : (g1 ? s : v1); i1 = g0 ? i0 : (g1 ? n : i1);
            v0 = g0 ? s : v0; i0 = g0 ? n : i0;
        } }
        int mycnt = 0, r0 = 0, r1 = 0, r2 = 0; const unsigned long long lt = (1ull << lane) - 1ull;
#pragma unroll 1
        for (int j = 0; j < i; ++j) {
            const bool s0 = (i0 == j), s1 = (i1 == j), s2 = (i2 == j);
            const unsigned long long mk = __ballot(s0 || s1 || s2);
            const int rk = __builtin_popcountll(mk & lt);
            mycnt = (lane == j) ? __builtin_popcountll(mk) : mycnt;
            r0 = s0 ? rk : r0; r1 = s1 ? rk : r1; r2 = s2 ? rk : r2;
        }
        int base = 0;
        if (lane < i && mycnt > 0) base = atomicAdd(cntq + bh * NBLK + lane, mycnt);
        const int b0 = __shfl(base, i0 & 63), b1 = __shfl(base, i1 & 63), b2 = __shfl(base, i2 & 63);
        if (i0 < i) lq[(size_t)(bh * NBLK + i0) * LQCAP + b0 + r0] = t * 4 + 0;
        if (i1 < i) lq[(size_t)(bh * NBLK + i1) * LQCAP + b1 + r1] = t * 4 + 1;
        if (i2 < i) lq[(size_t)(bh * NBLK + i2) * LQCAP + b2 + r2] = t * 4 + 2;
    }
}

template <bool OWN>
__device__ __forceinline__ void block_unit(int b, int h, int kblk, const int* __restrict__ lqp, int row_lo, int row_hi,
                                           const half_t* __restrict__ Q, const half_t* __restrict__ K, const half_t* __restrict__ V,
                                           half_t* parto, float* partml, half_t* O, float* ssq, char* shm) {
    int tid_ = threadIdx.x; asm volatile("" : "+v"(tid_));
    const int tid = tid_, lane = tid & 63, r32 = lane & 31, hi = lane >> 5; const int wid = __builtin_amdgcn_readfirstlane(tid >> 6);
    const long rowbase = (long)b * SEQ;
    const half_t* Kh = K + rowbase * QP + h * HD; const half_t* Vh = V + rowbase * QP + h * HD;
    const unsigned lds0 = (unsigned)(uintptr_t)shm; const lds_cptr shm3 = (lds_cptr)shm;
    {
        const half_t* ksrc = Kh + ((long)kblk * MBLK + lane) * QP + wid * 8;
        const half_t* vsrc = Vh + ((long)kblk * MBLK + 16 * (wid & 3) + (lane >> 2)) * QP + (wid >> 2) * 32 + (lane & 3) * 8;
        const unsigned kdst = lds0 + BLK_K + wid * 1024, vdst = lds0 + BLK_V + wid * 1024;
#pragma unroll
        for (int t4 = 0; t4 < 4; ++t4) { glds16(ksrc + (long)t4 * KVBLK * QP, (unsigned)__builtin_amdgcn_readfirstlane(kdst + t4 * 8192)); glds16(vsrc + (long)t4 * KVBLK * QP, (unsigned)__builtin_amdgcn_readfirstlane(vdst + t4 * 8192)); }
    }
    float* wsf = (float*)(shm + BLK_WS) + wid * 128;
    const int nchunk = OWN ? NW : ((row_hi - row_lo + 31) >> 5);
    const int ntw = OWN ? (wid >> 1) + 1 : 4;
    asm volatile("s_waitcnt vmcnt(0)\n\ts_barrier" ::: "memory");
    for (int c = wid; c < nchunk; c += NW) {
        int tq, kslot = 0; bool valid = true;
        if constexpr (OWN) { tq = kblk * MBLK + wid * QBLK + r32; }
        else { const int ix = row_lo + 32 * c + r32; valid = ix < row_hi; const int e = lqp[valid ? ix : row_lo]; tq = e >> 2; kslot = e & 3; }
        const half_t* qp = Q + (rowbase + tq) * QP + h * HD + hi * 8;
        h8 qr[4];
#pragma unroll
        for (int d0 = 0; d0 < 4; ++d0) qr[d0] = *reinterpret_cast<const h8*>(qp + d0 * 16);
        f32x16 p[4][2];
#pragma unroll
        for (int t4 = 0; t4 < 4; ++t4) { p[t4][0] = f32x16{}; p[t4][1] = f32x16{};
            if (t4 < ntw) {
                const lds_cptr kp = shm3 + BLK_K + t4 * 8192 + hi * 1024 + r32 * 16;
#pragma unroll
                for (int d0 = 0; d0 < 4; ++d0) { const h8 k0 = *(const LAS h8*)(kp + d0 * 2048), k1 = *(const LAS h8*)(kp + d0 * 2048 + 512);
                    p[t4][0] = MF16(k0, qr[d0], p[t4][0]); p[t4][1] = MF16(k1, qr[d0], p[t4][1]); }
                if constexpr (OWN) cmask(p[t4][0], p[t4][1], t4, wid * QBLK + r32, hi);
            } }
        float m = -INFINITY;
#pragma unroll
        for (int t4 = 0; t4 < 4; ++t4) if (t4 < ntw) {
#pragma unroll
            for (int r = 0; r < 16; ++r) m = __builtin_fmaxf(m, __builtin_fmaxf(p[t4][0][r], p[t4][1][r])); }
        { auto rr = __builtin_amdgcn_permlane32_swap(__float_as_uint(m), __float_as_uint(m), false, false); m = __builtin_fmaxf(__uint_as_float(rr[0]), __uint_as_float(rr[1])); }
        float l = 0.f;
#pragma unroll
        for (int t4 = 0; t4 < 4; ++t4) if (t4 < ntw) {
#pragma unroll
            for (int r = 0; r < 16; ++r) { p[t4][0][r] = __builtin_amdgcn_exp2f(p[t4][0][r] - m); p[t4][1][r] = __builtin_amdgcn_exp2f(p[t4][1][r] - m); l += p[t4][0][r] + p[t4][1][r]; } }
        { auto rr = __builtin_amdgcn_permlane32_swap(__float_as_uint(l), __float_as_uint(l), false, false); l = __uint_as_float(rr[0]) + __uint_as_float(rr[1]); }
        f32x16 o[2]; o[0] = f32x16{}; o[1] = f32x16{};
#pragma unroll
        for (int t4 = 0; t4 < 4; ++t4) if (t4 < ntw) {
            u32x4 pw0, pw1, pw2, pw3;
#define PKW(P, B) pkh(P[B], P[B + 1])
            pw0 = (u32x4){PKW(p[t4][0], 0), PKW(p[t4][0], 2), PKW(p[t4][0], 4), PKW(p[t4][0], 6)}; pw1 = (u32x4){PKW(p[t4][0], 8), PKW(p[t4][0], 10), PKW(p[t4][0], 12), PKW(p[t4][0], 14)};
            pw2 = (u32x4){PKW(p[t4][1], 0), PKW(p[t4][1], 2), PKW(p[t4][1], 4), PKW(p[t4][1], 6)}; pw3 = (u32x4){PKW(p[t4][1], 8), PKW(p[t4][1], 10), PKW(p[t4][1], 12), PKW(p[t4][1], 14)};
#undef PKW
            { const lds_cptr vp = shm3 + BLK_V + t4 * 8192 + ((lane >> 4) & 1) * 32 + (lane & 3) * 8 + (4 * hi + ((lane & 15) >> 2)) * 64;
              s16x4 vl[2][4], vh[2][4];
#pragma unroll
              for (int d0 = 0; d0 < 2; ++d0)
#pragma unroll
                  for (int ks = 0; ks < 4; ++ks) { vl[d0][ks] = vtr(vp + d0 * 4096 + ks * 1024); vh[d0][ks] = vtr(vp + d0 * 4096 + ks * 1024 + 512); }
#define VF(d, k) __builtin_bit_cast(h8, (__attribute__((ext_vector_type(8))) short){vl[d][k][0], vl[d][k][1], vl[d][k][2], vl[d][k][3], vh[d][k][0], vh[d][k][1], vh[d][k][2], vh[d][k][3]})
#pragma unroll
              for (int d0 = 0; d0 < 2; ++d0) { o[d0] = MF16(__builtin_bit_cast(h8, pw0), VF(d0, 0), o[d0]); o[d0] = MF16(__builtin_bit_cast(h8, pw1), VF(d0, 1), o[d0]);
                  o[d0] = MF16(__builtin_bit_cast(h8, pw2), VF(d0, 2), o[d0]); o[d0] = MF16(__builtin_bit_cast(h8, pw3), VF(d0, 3), o[d0]); }
#undef VF
            } }
        const int pidx = ((int)((rowbase + tq) * NH + h)) * 3 + kslot;
        if (hi == 0) { wsf[r32] = __builtin_amdgcn_rcpf(l); wsf[32 + r32] = m; wsf[64 + r32] = l; ((int*)wsf)[96 + r32] = valid ? pidx : -1; }
        asm volatile("s_waitcnt lgkmcnt(0)" ::: "memory");
        f32x2 pm[4][3]; h8 po[4][3]; int lr8 = lane >> 3, ch = lane & 7; const int nsel = kblk < 3 ? kblk : 3;
        if constexpr (OWN) {
            asm volatile("" : "+v"(lr8), "+v"(ch));
#pragma unroll
            for (int i = 0; i < 4; ++i) { const int trow = kblk * MBLK + wid * QBLK + i * 8 + lr8; const size_t pb = ((size_t)(rowbase + trow) * NH + h) * 3;
#pragma unroll
                for (int k = 0; k < 3; ++k) { if (k < nsel) { pm[i][k] = *(const f32x2*)(partml + (pb + k) * 2); po[i][k] = *(const h8*)(parto + (pb + k) * HD + ch * 8); }
                                              else { pm[i][k] = (f32x2){-INFINITY, 0.f}; po[i][k] = h8{}; } } }
        }
        half_t* stg = (half_t*)(shm + BLK_OST) + wid * 2048;
#pragma unroll
        for (int r = 0; r < 16; ++r) { const int orow = crow(r, hi); const float rl = wsf[orow];
#pragma unroll
            for (int d0 = 0; d0 < 2; ++d0) stg[orow * 64 + d0 * 32 + r32] = (half_t)(o[d0][r] * rl); }
        asm volatile("s_waitcnt lgkmcnt(0)" ::: "memory");
        if constexpr (!OWN) {
#pragma unroll
            for (int i = 0; i < 4; ++i) { const int row = i * 8 + (lane >> 3), ch = lane & 7; const u32x4 v = *(const u32x4*)(stg + row * 64 + ch * 8);
                const int dst = ((const int*)wsf)[96 + row];
                if (dst >= 0) { *(u32x4*)(parto + (size_t)dst * HD + ch * 8) = v; if (ch == 0) *(f32x2*)(partml + (size_t)dst * 2) = (f32x2){wsf[32 + row], wsf[64 + row]}; } }
        } else {
#pragma unroll
            for (int i = 0; i < 4; ++i) { const int row = i * 8 + lr8; const u32x4 v = *(const u32x4*)(stg + row * 64 + ch * 8);
                const int trow = kblk * MBLK + wid * QBLK + row;
                const float m0 = wsf[32 + row], l0 = wsf[64 + row];
                float M = m0;
#pragma unroll
                for (int k = 0; k < 3; ++k) M = __builtin_fmaxf(M, pm[i][k][0]);
                float w0 = l0 * __builtin_amdgcn_exp2f(m0 - M), W = w0; float wk[3];
#pragma unroll
                for (int k = 0; k < 3; ++k) { wk[k] = pm[i][k][1] * __builtin_amdgcn_exp2f(pm[i][k][0] - M); W += wk[k]; }
                const float iW = __builtin_amdgcn_rcpf(W);
                const h8 ov = __builtin_bit_cast(h8, v); float acc[8];
#pragma unroll
                for (int e = 0; e < 8; ++e) acc[e] = (float)ov[e] * w0;
#pragma unroll
                for (int k = 0; k < 3; ++k)
#pragma unroll
                    for (int e = 0; e < 8; ++e) acc[e] += (float)po[i][k][e] * wk[k];
                u32x4 w; float sq = 0.f; half_t hv[8];
#pragma unroll
                for (int e = 0; e < 8; ++e) { hv[e] = (half_t)(acc[e] * iW); const float f = (float)hv[e]; sq += f * f; }
                w.x = pkh((float)hv[0], (float)hv[1]); w.y = pkh((float)hv[2], (float)hv[3]); w.z = pkh((float)hv[4], (float)hv[5]); w.w = pkh((float)hv[6], (float)hv[7]);
                *(u32x4*)(O + (size_t)(rowbase + trow) * OP + h * HD + ch * 8) = w;
                sq += __shfl_xor(sq, 1); sq += __shfl_xor(sq, 2); sq += __shfl_xor(sq, 4);
                if (ch == 0) ssq[(size_t)(rowbase + trow) * 16 + h] = sq; }
        }
        asm volatile("s_waitcnt lgkmcnt(0)" ::: "memory");
    }
    asm volatile("s_waitcnt lgkmcnt(0)\n\ts_barrier" ::: "memory");
}
#undef SBAR
#undef MF16
}

constexpr int NWAVES = 8;
constexpr int NPHASE = 8;

struct Args {
    const float* in[16]; float* out; unsigned char* ws;
    double inv_freq[8];
    int ph_lo, ph_hi, li, pad;
};
struct Frame {
    LAS unsigned char* lds; int tid, lane, wave, vcu, G;
    const float *x, *norm_mix_g, *w_in, *b_forget, *fox_g, *moba_g, *w_out, *norm_ffn_g, *wrg, *brg, *wre, *bre, *wg, *wu, *wd, *gfin;
    float* out; unsigned char* ws;
};
#define LDS_WAIT() asm volatile("s_waitcnt lgkmcnt(0)" ::: "memory")

struct TItem { const float* src; const float* gs; half_t* dst; int spitch, K, drow0, k0, nt; float f8; };
__device__ __forceinline__ void p0_item_load(const TItem& t, f32x4 (&v)[8], int lane) {
    const int lr = lane >> 3, lc = (lane & 7) * 4;
#pragma unroll
    for (int i = 0; i < 8; ++i) v[i] = __builtin_nontemporal_load((const GAS f32x4*)(t.src + (size_t)(t.k0 + 8 * i + lr) * t.spitch + lc));
}
__device__ __forceinline__ void p0_item_finish(const TItem& t, f32x4 (&v)[8], LAS float* scr, int lane) {
    const int lr = lane >> 3, lc = (lane & 7) * 4;
    if (t.gs) {
#pragma unroll
        for (int i = 0; i < 8; ++i) v[i] = v[i] * t.gs[t.k0 + 8 * i + lr]; }
    if (t.f8 != 0.f) {
#pragma unroll
        for (int i = 0; i < 8; ++i) v[i] = v[i] * t.f8; }
#pragma unroll
    for (int i = 0; i < 8; ++i) { LAS float* s = scr + (8 * i + lr) * 33 + lc; s[0] = v[i][0]; s[1] = v[i][1]; s[2] = v[i][2]; s[3] = v[i][3]; }
    LDS_WAIT(); asm volatile("" ::: "memory");
    const int c = lane & 7;
#pragma unroll
    for (int j = 0; j < 4; ++j) { const int n = (lane >> 3) + 8 * j; const LAS float* s = scr + (8 * c) * 33 + n;
        if (t.f8 != 0.f) {
            float q[8];
#pragma unroll
            for (int e = 0; e < 8; ++e) q[e] = __builtin_fminf(__builtin_fmaxf(s[e * 33], -448.f), 448.f);
            int w0 = 0, w1 = 0;
            w0 = __builtin_amdgcn_cvt_pk_fp8_f32(q[0], q[1], w0, false); w0 = __builtin_amdgcn_cvt_pk_fp8_f32(q[2], q[3], w0, true);
            w1 = __builtin_amdgcn_cvt_pk_fp8_f32(q[4], q[5], w1, false); w1 = __builtin_amdgcn_cvt_pk_fp8_f32(q[6], q[7], w1, true);
            __builtin_nontemporal_store((u32x2){(unsigned)w0, (unsigned)w1}, (GAS u32x2*)((unsigned char*)t.dst + (size_t)(t.drow0 + n) * t.K + t.k0 + 8 * c));
            continue; }
        u32x4 o; o.x = pkh(s[0 * 33], s[1 * 33]); o.y = pkh(s[2 * 33], s[3 * 33]); o.z = pkh(s[4 * 33], s[5 * 33]); o.w = pkh(s[6 * 33], s[7 * 33]);
        GAS u32x4* dp = (GAS u32x4*)(t.dst + (size_t)(t.drow0 + n) * t.K + t.k0 + 8 * c);
        if (t.nt) __builtin_nontemporal_store(o, dp); else *dp = o; }
    LDS_WAIT(); asm volatile("" ::: "memory");
}
__device__ __forceinline__ float wave_sum8(const float (&d)[8], int lane) {
    const bool b5 = lane & 32, b4 = lane & 16, b3 = lane & 8;
    float u[4];
#pragma unroll
    for (int i = 0; i < 4; ++i) { const float keep = b5 ? d[4 + i] : d[i], give = b5 ? d[i] : d[4 + i]; u[i] = keep + __shfl_xor(give, 32); }
    float w[2];
#pragma unroll
    for (int i = 0; i < 2; ++i) { const float keep = b4 ? u[2 + i] : u[i], give = b4 ? u[i] : u[2 + i]; w[i] = keep + __shfl_xor(give, 16); }
    float z; { const float keep = b3 ? w[1] : w[0], give = b3 ? w[0] : w[1]; z = keep + __shfl_xor(give, 8); }
    z += __shfl_xor(z, 4); z += __shfl_xor(z, 2); z += __shfl_xor(z, 1);
    return z;
}
__device__ __forceinline__ void p0_prep(Frame& F, const Args& args) {
    unsigned char* ws = F.ws;
    half_t* W1T = (half_t*)(ws + WS_W1T); half_t* WOT = (half_t*)(ws + WS_WOT); half_t* WRT = (half_t*)(ws + WS_WRT); half_t* WGU = (half_t*)(ws + WS_WGU); half_t* WDT = (half_t*)(ws + WS_WD);
    half_t* XH = (half_t*)(ws + WS_XH); float* RSTD1 = (float*)(ws + WS_RSTD1); float* LOGF = (float*)(ws + WS_LOGF); float* KSUM = (float*)(ws + WS_KSUM);
    float2* ROPE = (float2*)(ws + WS_ROPE); int* CNT = (int*)(ws + WS_CNT);
    const int gw = F.vcu * NWAVES + F.wave, NGW = F.G * NWAVES; const int gt = F.vcu * 512 + F.tid, NGT = F.G * 512;
    for (int i = gt; i < BATCH * NBLK * 512; i += NGT) KSUM[i] = 0.f;
    if (gt < BATCH * 8 * 4) ((unsigned*)(ws + WS_NRM))[gt] = 0u;
    if (gt < 160) ((int*)(ws + WS_PRDY))[gt] = 0;
    if (gt < 2 * BATCH * NH * NBLK) ((int*)(ws + WS_CNTQ))[gt] = 0;
    for (int idx = gt; idx < SEQ * 8; idx += NGT) { const int s = idx >> 3, i = idx & 7; const double ang = (double)s * args.inv_freq[i]; const double TWO_PI = 6.283185307179586476925286766559;
        const double n = rint(ang / TWO_PI); const float r = (float)(ang - n * TWO_PI); ROPE[idx] = make_float2(cosf(r), sinf(r)); }
    for (int idx = gt; idx < 48 * DM; idx += NGT) { const int n = idx / DM, k = idx % DM; float v = 0.f;
        if (n < 4) v = F.wrg[(size_t)k * 4 + n] * F.norm_ffn_g[k]; else if (n < 36) v = F.wre[(size_t)k * 32 + (n - 4)] * F.norm_ffn_g[k];
        WRT[idx] = (half_t)v; }
    LAS float* wf = (LAS float*)(F.lds + 98304);
    for (int i = F.tid; i < 8 * DM; i += 512) { const int k = i >> 3, j = i & 7; wf[j * DM + k] = F.norm_mix_g[k] * F.w_in[(size_t)k * INC + 1536 + j]; }
    __syncthreads();
    LAS float* scr = (LAS float*)(F.lds + F.wave * 8704);
    constexpr int I_IN = 16 * 96, I_OUT = 16 * 32, I_GU = NEXP * 16 * 16, I_D = NEXP * 4 * 32, NITEMS = I_IN + I_OUT + I_GU + I_D;
    auto decode = [&](int r, TItem& t) {
        if (r < I_IN) { const int kb = r / 96, nb = r % 96, n0 = nb * 32; t = TItem{F.w_in + (n0 < 1536 ? n0 : n0 + 8), F.norm_mix_g, W1T, INC, DM, n0, kb * 64, 0, 0.f}; return; } r -= I_IN;
        if (r < I_OUT) { const int kb = r / 32, nb = r % 32, k0 = kb * 64; t = TItem{F.w_out + nb * 32, (k0 < 512 ? F.fox_g : F.moba_g - 512), WOT, DM, DM, nb * 32, k0, 0, 0.f}; return; } r -= I_OUT;
        if (r < I_GU) { const int e = r >> 8, q = r & 255, kb = q >> 4, nb = q & 15, drow = nb * 32;
            const int j = drow >> 8, rr = drow & 255; const bool up = rr >= 128; const int f0 = 128 * j + (rr & 127);
            t = TItem{(up ? F.wu : F.wg) + (size_t)e * DM * DEXP + f0, F.norm_ffn_g, (half_t*)((unsigned char*)WGU + (size_t)e * 512 * DM), DEXP, DM, drow, kb * 64, 1, 64.f}; return; } r -= I_GU;
        { const int e = r >> 7, q = r & 127, kb = q >> 5, nb = q & 31;
            t = TItem{F.wd + (size_t)e * DEXP * DM + nb * 32, nullptr, (half_t*)((unsigned char*)WDT + (size_t)e * DM * DEXP), DM, DEXP, nb * 32, kb * 64, 1, 32.f}; }
    };
    for (int it = gw; it < NITEMS; it += 2 * NGW) {
        TItem ta, tb; f32x4 va[8], vb[8]; const bool two = it + NGW < NITEMS;
        decode(it, ta); p0_item_load(ta, va, F.lane);
        if (two) { decode(it + NGW, tb); p0_item_load(tb, vb, F.lane); }
        p0_item_finish(ta, va, scr, F.lane);
        if (two) p0_item_finish(tb, vb, scr, F.lane);
    }
    for (int m0 = gw; m0 < T; m0 += 2 * NGW) {
        const int m1 = (m0 + NGW < T) ? m0 + NGW : m0;
        f32x4 v[2][4];
#pragma unroll
        for (int j = 0; j < 4; ++j) { v[0][j] = __builtin_nontemporal_load((const GAS f32x4*)(F.x + (size_t)m0 * DM) + F.lane + 64 * j); v[1][j] = __builtin_nontemporal_load((const GAS f32x4*)(F.x + (size_t)m1 * DM) + F.lane + 64 * j); }
#pragma unroll
        for (int r = 0; r < 2; ++r) {
            const int m = r ? m1 : m0; if (r && m1 == m0) break;
            asm volatile("" : "+v"(wf));
            float ss = 0.f; float d[8] = {0.f, 0.f, 0.f, 0.f, 0.f, 0.f, 0.f, 0.f};
#pragma unroll
            for (int j = 0; j < 4; ++j) ss += (v[r][j].x * v[r][j].x + v[r][j].y * v[r][j].y) + (v[r][j].z * v[r][j].z + v[r][j].w * v[r][j].w);
#pragma unroll
            for (int j = 0; j < 4; ++j)
#pragma unroll
                for (int jj = 0; jj < 8; ++jj) { const f32x4 w = *(const LAS f32x4*)(wf + jj * DM + 4 * (F.lane + 64 * j)); d[jj] += (v[r][j].x * w.x + v[r][j].y * w.y) + (v[r][j].z * w.z + v[r][j].w * w.w); }
            ss = wave_sum(ss);
            const float dv = wave_sum8(d, F.lane);
            const float rs = 1.0f / sqrtf(ss * (1.0f / DM) + EPS);
            GAS u32x2* o8 = (GAS u32x2*)(XH + (size_t)m * DM) + F.lane;
#pragma unroll
            for (int j = 0; j < 4; ++j) { u32x2 w; w.x = pkh(v[r][j].x, v[r][j].y); w.y = pkh(v[r][j].z, v[r][j].w); o8[64 * j] = w; }
            if ((F.lane & 7) == 0) {
                const int hh = F.lane >> 3;
                const float z = dv * rs + F.b_forget[hh];
                const float lf = fminf(z, 0.f) - log1pf(expf(-fabsf(z)));
                const int b = m / SEQ, s_ = m % SEQ;
                LOGF[((size_t)b * 8 + hh) * SEQ + s_] = lf;
                if (F.lane == 0) RSTD1[m] = rs;
            }
        }
    }
}

struct EpiQKV {
    static constexpr bool PERM = true, HAS_MID = false;
    half_t* QKV; const float* rstd1; const float2* rope; float* ksum; unsigned* nrm;
    __device__ __forceinline__ void mid(f32x4 (&)[2][2][4][2], const pg8::GUnit&, int, int) const {}
    __device__ __forceinline__ void unit_begin(const pg8::GUnit&) const {}
    __device__ __forceinline__ void operator()(const f32x4 (&acc)[2][2][4][2], const pg8::GUnit& u, int wr, int wc, int fr, int fq) const {
        asm volatile("" : "+v"(fr), "+v"(fq));
        const int kind = u.pn >> 1;
        const float cs = (kind == 0 || kind == 3) ? C2 : 1.0f;
        const bool rot = (kind == 3 || kind == 4) && ((wc & 1) == 0);
        const int row0 = u.pm * 256 + wr * 64 + fr, col0 = u.pn * 256 + wc * 32 + 8 * fq;
        float csum[2][8];
#pragma unroll
        for (int bj = 0; bj < 2; ++bj)
#pragma unroll
            for (int e = 0; e < 8; ++e) csum[bj][e] = 0.f;
        float nmx[2] = {0.f, 0.f};
#pragma unroll
        for (int ai = 0; ai < 2; ++ai)
#pragma unroll
            for (int m = 0; m < 4; ++m) {
                const int row = row0 + ai * 128 + m * 16; const float rs = rstd1[row] * cs;
                half_t* rowp = QKV + ((((size_t)kind * BATCH + (row >> 12)) * NH + (u.pn & 1) * 4 + (wc >> 1)) * SEQ + (row & (SEQ - 1))) * HD + (wc & 1) * 32 + 8 * fq;
                f32x4 c0, s0, c1, s1;
                if (rot) { const f32x4* rp = (const f32x4*)(rope + (size_t)(row & (SEQ - 1)) * 8); const f32x4 t0 = rp[0], t1 = rp[1], t2 = rp[2], t3 = rp[3];
                    c0 = (f32x4){t0[0], t0[2], t1[0], t1[2]}; s0 = (f32x4){t0[1], t0[3], t1[1], t1[3]}; c1 = (f32x4){t2[0], t2[2], t3[0], t3[2]}; s1 = (f32x4){t2[1], t2[3], t3[1], t3[3]}; }
#pragma unroll
                for (int bj = 0; bj < 2; ++bj) {
                    f32x4 v0 = acc[ai][bj][m][0] * rs, v1 = acc[ai][bj][m][1] * rs;
                    if (rot) {
                        f32x4 p0, p1;
#pragma unroll
                        for (int e = 0; e < 4; ++e) { p0[e] = __shfl_xor(v0[e], 16); p1[e] = __shfl_xor(v1[e], 16); }
                        if (fq == 0) { v0 = v0 * c0 - p0 * s0; v1 = v1 * c1 - p1 * s1; }
                        else if (fq == 1) { v0 = v0 * c0 + p0 * s0; v1 = v1 * c1 + p1 * s1; }
                    }
                    if (kind == 4) {
#pragma unroll
                        for (int e = 0; e < 4; ++e) { csum[bj][e] += v0[e]; csum[bj][4 + e] += v1[e]; }
                    }
                    if (kind <= 1) { float s = (v0[0] * v0[0] + v0[1] * v0[1]) + (v0[2] * v0[2] + v0[3] * v0[3]) + (v1[0] * v1[0] + v1[1] * v1[1]) + (v1[2] * v1[2] + v1[3] * v1[3]);
                        s += __shfl_xor(s, 16); s += __shfl_xor(s, 32); nmx[bj] = fmaxf(nmx[bj], s); }
                    u32x4 w; w.x = pkh(v0[0], v0[1]); w.y = pkh(v0[2], v0[3]); w.z = pkh(v1[0], v1[1]); w.w = pkh(v1[2], v1[3]);
                    if (kind == 0 || kind == 3) __builtin_nontemporal_store(w, (u32x4*)(rowp + (size_t)bj * 2 * SEQ * HD));
                    else *(u32x4*)(rowp + (size_t)bj * 2 * SEQ * HD) = w;
                }
            }
        if (kind <= 1) {
#pragma unroll
            for (int bj = 0; bj < 2; ++bj) { float s = nmx[bj]; s = fmaxf(s, __shfl_xor(s, 1)); s = fmaxf(s, __shfl_xor(s, 2)); s = fmaxf(s, __shfl_xor(s, 4)); s = fmaxf(s, __shfl_xor(s, 8));
                const int head = (u.pn & 1) * 4 + bj * 2 + (wc >> 1);
                if (fr == 0 && fq == 0) atomicMax(nrm + (((u.pm >> 4) * 8 + head) * 2 + kind) * 2 + (wc & 1), __float_as_uint(s * 1.002f)); }
        }
        if (kind == 4) {
            float* kp = ksum + (size_t)u.pm * 512 + (u.pn - 8) * 256 + wc * 32 + 8 * fq;
#pragma unroll
            for (int bj = 0; bj < 2; ++bj)
#pragma unroll
                for (int e = 0; e < 8; ++e) { float s = csum[bj][e]; s += __shfl_xor(s, 1); s += __shfl_xor(s, 2); s += __shfl_xor(s, 4); s += __shfl_xor(s, 8);
                    if (fr == 0) atomicAdd(kp + bj * 128 + e, s); }
        }
    }
};

__device__ __forceinline__ void cumsum_seq(const float* lf, float* cb, int lane) {
    const f32x4* p = (const f32x4*)(lf + lane * 64); float tot = 0.f;
#pragma unroll
    for (int i = 0; i < 16; ++i) { const f32x4 v = p[i]; tot += (v[0] + v[1]) + (v[2] + v[3]); }
    float inc = tot;
#pragma unroll
    for (int o = 1; o < 64; o <<= 1) { const float n = __shfl_up(inc, o); if (lane >= o) inc += n; }
    float run = inc - tot;
    f32x4* q = (f32x4*)(cb + lane * 64);
#pragma unroll
    for (int i = 0; i < 16; ++i) { const f32x4 v = p[i]; f32x4 o; run += v[0]; o[0] = run * LOG2E; run += v[1]; o[1] = run * LOG2E; run += v[2]; o[2] = run * LOG2E; run += v[3]; o[3] = run * LOG2E; q[i] = o; }
}

struct EpiOut {
    static constexpr bool PERM = true, HAS_MID = true;
    const float* x; half_t* h2; const float* ssq; LAS f32x2* rowf; unsigned char* h8q;
    __device__ __forceinline__ void rowscales(int row, float& rf, float& rm) const {
        const f32x4* sp = (const f32x4*)(ssq + (size_t)row * 16); const f32x4 a = sp[0], b = sp[1], c = sp[2], d = sp[3];
        rf = 1.0f / sqrtf(((a[0] + a[1]) + (a[2] + a[3]) + (b[0] + b[1]) + (b[2] + b[3])) * (1.0f / 512.0f) + EPS);
        rm = 1.0f / sqrtf(((c[0] + c[1]) + (c[2] + c[3]) + (d[0] + d[1]) + (d[2] + d[3])) * (1.0f / 512.0f) + EPS);
    }
    __device__ __forceinline__ void unit_begin(const pg8::GUnit& u) const {
        int t = threadIdx.x; asm volatile("" : "+v"(t));
        if (t < 256) { float rf, rm; rowscales(u.pm * 256 + t, rf, rm); rowf[u.par * 256 + t] = (f32x2){rf / rm, rm}; }
    }
    __device__ __forceinline__ void mid(f32x4 (&acc)[2][2][4][2], const pg8::GUnit& u, int wr, int fr) const {
        asm volatile("" : "+v"(fr));
#pragma unroll
        for (int ai = 0; ai < 2; ++ai)
#pragma unroll
            for (int m = 0; m < 4; ++m) { const float sc = rowf[u.par * 256 + ai * 128 + wr * 64 + m * 16 + fr][0];
#pragma unroll
                for (int bj = 0; bj < 2; ++bj)
#pragma unroll
                    for (int n = 0; n < 2; ++n) acc[ai][bj][m][n] *= sc; }
    }
    __device__ __forceinline__ void operator()(const f32x4 (&acc)[2][2][4][2], const pg8::GUnit& u, int wr, int wc, int fr, int fq) const {
        asm volatile("" : "+v"(fr), "+v"(fq));
        const int row0 = u.pm * 256 + wr * 64 + fr, col0 = u.pn * 256 + wc * 32 + 8 * fq;
#pragma unroll
        for (int ai = 0; ai < 2; ++ai)
#pragma unroll
            for (int m = 0; m < 4; ++m) { const int row = row0 + ai * 128 + m * 16; const float rm = rowf[u.par * 256 + ai * 128 + wr * 64 + m * 16 + fr][1];
                const size_t off = (size_t)row * DM + col0;
#pragma unroll
                for (int bj = 0; bj < 2; ++bj) {
#if MOBA_SPARSE
                    const f32x4 x0 = *(const f32x4*)(x + off + bj * 128), x1 = *(const f32x4*)(x + off + bj * 128 + 4);
#else
                    const h8 xh = *(const h8*)(h2 + off + bj * 128);
                    const f32x4 x0 = {(float)xh[0], (float)xh[1], (float)xh[2], (float)xh[3]}, x1 = {(float)xh[4], (float)xh[5], (float)xh[6], (float)xh[7]};
#endif
                    const f32x4 v0 = x0 + acc[ai][bj][m][0] * rm, v1 = x1 + acc[ai][bj][m][1] * rm;
                    u32x4 w; w.x = pkh(v0[0], v0[1]); w.y = pkh(v0[2], v0[3]); w.z = pkh(v1[0], v1[1]); w.w = pkh(v1[2], v1[3]);
                    *(u32x4*)(h2 + off + bj * 128) = w;
                    { float q[8];
#pragma unroll
                      for (int e = 0; e < 4; ++e) { q[e] = __builtin_fminf(__builtin_fmaxf(v0[e] * 4.0f, -448.f), 448.f); q[4 + e] = __builtin_fminf(__builtin_fmaxf(v1[e] * 4.0f, -448.f), 448.f); }
                      int w0 = 0, w1 = 0;
                      w0 = __builtin_amdgcn_cvt_pk_fp8_f32(q[0], q[1], w0, false); w0 = __builtin_amdgcn_cvt_pk_fp8_f32(q[2], q[3], w0, true);
                      w1 = __builtin_amdgcn_cvt_pk_fp8_f32(q[4], q[5], w1, false); w1 = __builtin_amdgcn_cvt_pk_fp8_f32(q[6], q[7], w1, true);
                      *(u32x2*)(h8q + off + bj * 128) = (u32x2){(unsigned)w0, (unsigned)w1}; } }
                asm volatile("" ::: "memory"); }
    }
};

struct OutOrder {
    static constexpr bool GATHER = false, DEFER = true;
    const char* A; const char* Bt; int* q3; int* prdy; volatile LAS int* slot; mutable int pend;
    __device__ __forceinline__ void prefetch(int) const { if (threadIdx.x == 0) pend = __hip_atomic_fetch_add(q3, 1, __ATOMIC_RELAXED, __HIP_MEMORY_SCOPE_AGENT); }
    __device__ __forceinline__ bool next(int i, pg8::GUnit& u) const {
        if (i == 0) prefetch(0);
        if (threadIdx.x == 0) {
            const int U = pend;
            if (U < 512) { const int b_ = (U >> 2) & 7, c_ = (U >> 5) & 3, pos = U >> 7, qb = (pos == 0) ? 15 - c_ : (pos == 1) ? 8 + c_ : (pos == 2) ? 7 - c_ : c_;
                int* w = prdy + b_ * NBLK + qb; unsigned sp = 0;
                while (__hip_atomic_load(w, __ATOMIC_RELAXED, __HIP_MEMORY_SCOPE_AGENT) < 128) { __builtin_amdgcn_s_sleep(2); if (++sp > (1u << 22)) break; } }
            slot[i & 1] = U;
        }
        asm volatile("s_waitcnt lgkmcnt(0)" ::: "memory"); __builtin_amdgcn_s_barrier(); asm volatile("" ::: "memory");
        const int U = slot[i & 1]; if (U >= 512) return false;
        const int pn = U & 3, b = (U >> 2) & 7, c = (U >> 5) & 3, pos = U >> 7, qb = (pos == 0) ? 15 - c : (pos == 1) ? 8 + c : (pos == 2) ? 7 - c : c;
        u.pm = b * NBLK + qb; u.pn = pn; u.aux = 0; u.A = A + (size_t)u.pm * 256 * DM * 2; u.B = Bt + (size_t)pn * 256 * DM * 2; return true; }
    __device__ __forceinline__ unsigned aoff(const pg8::GUnit&, int row, int C, int K_) const { return (unsigned)(row * K_ + C) * 2u; }
};

__device__ __forceinline__ void p4_router(Frame& F) {
    unsigned char* ws = F.ws;
    const half_t* H2 = (const half_t*)(ws + WS_XH); const half_t* WRT = (const half_t*)(ws + WS_WRT);
    TokInfo* TOK = (TokInfo*)(ws + WS_TOK); int* CNT = (int*)(ws + WS_CNT);
    int* LTOK = (int*)(ws + WS_LTOK); float* LRS = (float*)(ws + WS_LRS); float* LCW = (float*)(ws + WS_LCW);
    LAS int* hist = (LAS int*)(F.lds + LDSX_OFF + LX_HIST); LAS int* ebase = (LAS int*)(F.lds + LDSX_OFF + LX_EBASE);
    LAS float* lgw = (LAS float*)(F.lds + 98304 + F.wave * 3072);
    const int r16 = F.lane & 15, q = F.lane >> 4;
    const LAS unsigned char* wlds = F.lds;
    for (int i = F.tid; i < 48 * 128; i += 512) { const int r = i >> 7, kc = i & 127; const u32x4 v = *(const u32x4*)(WRT + (size_t)r * DM + kc * 8);
        *(LAS u32x4*)(F.lds + r * 2048 + (((kc & ~15) | ((kc ^ r) & 15)) << 4)) = v; }
    __syncthreads();
    for (int rb = F.vcu; rb < T / 128; rb += F.G) {
        if (F.tid < 32) hist[F.tid] = 0;
        __syncthreads();
        const int row = rb * 128 + F.wave * 16 + r16;
        const half_t* hr = H2 + (size_t)row * DM + 8 * q;
        f32x4 acc0 = {0.f, 0.f, 0.f, 0.f}, acc1 = acc0, acc2 = acc0; float ss = 0.f;
        h8 av[32];
#pragma unroll
        for (int ks = 0; ks < 32; ++ks) av[ks] = *(const h8*)(hr + 32 * ks);
#pragma unroll
        for (int ks = 0; ks < 32; ++ks) {
            { float t = 0.f;
#pragma unroll
              for (int j = 0; j < 8; ++j) { const float xf = (float)av[ks][j]; t += xf * xf; }
              ss += t; }
            const int kc = 4 * ks + q;
            const LAS unsigned char* wb = wlds + r16 * 2048 + (((kc & ~15) | ((kc ^ r16) & 15)) << 4);
            const h8 b0 = *(const LAS h8*)(wb), b1 = *(const LAS h8*)(wb + 16 * 2048), b2 = *(const LAS h8*)(wb + 32 * 2048);
            acc0 = __builtin_amdgcn_mfma_f32_16x16x32_f16(av[ks], b0, acc0, 0, 0, 0);
            acc1 = __builtin_amdgcn_mfma_f32_16x16x32_f16(av[ks], b1, acc1, 0, 0, 0);
            acc2 = __builtin_amdgcn_mfma_f32_16x16x32_f16(av[ks], b2, acc2, 0, 0, 0);
        }
        ss += __shfl_xor(ss, 16); ss += __shfl_xor(ss, 32);
        const float rs = 1.0f / sqrtf(ss * (1.0f / DM) + EPS);
#pragma unroll
        for (int rg = 0; rg < 4; ++rg) { lgw[(4 * q + rg) * 48 + r16] = acc0[rg]; lgw[(4 * q + rg) * 48 + 16 + r16] = acc1[rg]; lgw[(4 * q + rg) * 48 + 32 + r16] = acc2[rg]; }
        LDS_WAIT(); asm volatile("" ::: "memory");
        int e1 = 0, e2 = 0, pl1 = 0, pl2 = 0; float w1 = 0.f, w2 = 0.f;
        if (F.lane < 16) {
            const LAS float* lr = lgw + F.lane * 48;
            float lg[4];
#pragma unroll
            for (int j = 0; j < 4; ++j) lg[j] = lr[j] * rs + F.brg[j];
            int gi = 0; float gm = lg[0];
#pragma unroll
            for (int j = 1; j < 4; ++j) if (lg[j] > gm) { gm = lg[j]; gi = j; }
            float gs = 0.f;
#pragma unroll
            for (int j = 0; j < 4; ++j) gs += expf(lg[j] - gm);
            const float gtop = 1.0f / gs;
            const LAS float* el = lr + 4 + gi * 8; const float* be = F.bre + gi * 8;
            float ev[8];
#pragma unroll
            for (int j = 0; j < 8; ++j) ev[j] = el[j] * rs + be[j];
            int i1 = 0; float m1 = ev[0];
#pragma unroll
            for (int j = 1; j < 8; ++j) if (ev[j] > m1) { m1 = ev[j]; i1 = j; }
            int i2 = -1; float m2 = -INFINITY;
#pragma unroll
            for (int j = 0; j < 8; ++j) if (j != i1 && ev[j] > m2) { m2 = ev[j]; i2 = j; }
            if (i2 < 0) { i2 = (i1 == 0) ? 1 : 0; m2 = ev[i2]; }
            const float x2e = expf(m2 - m1);
            w1 = gtop / (1.0f + x2e); w2 = gtop * x2e / (1.0f + x2e);
            e1 = gi * 8 + i1; e2 = gi * 8 + i2;
            pl1 = __hip_atomic_fetch_add(hist + e1, 1, __ATOMIC_RELAXED, __HIP_MEMORY_SCOPE_WORKGROUP); pl2 = __hip_atomic_fetch_add(hist + e2, 1, __ATOMIC_RELAXED, __HIP_MEMORY_SCOPE_WORKGROUP);
        }
        __syncthreads();
        if (F.tid < 32) ebase[F.tid] = atomicAdd(CNT + F.tid, hist[F.tid]);
        __syncthreads();
        if (F.lane < 16) {
            const int p1 = ebase[e1] + pl1, p2 = ebase[e2] + pl2;
            TokInfo ti; ti.e1 = e1; ti.e2 = e2; ti.w1 = w1; ti.w2 = w2; ti.rstd2 = rs; ti.pad0 = p1; ti.pad1 = p2; ti.pad2 = 0;
            TOK[row] = ti;
            LTOK[(size_t)e1 * T + p1] = row; LRS[(size_t)e1 * T + p1] = rs; LCW[(size_t)e1 * T + p1] = w1;
            LTOK[(size_t)e2 * T + p2] = row; LRS[(size_t)e2 * T + p2] = rs; LCW[(size_t)e2 * T + p2] = w2;
        }
        __syncthreads();
    }
}

__device__ __forceinline__ void moe_tile_table(Frame& F) {
    LAS int* toff = (LAS int*)(F.lds + LDSX_OFF + LX_TOFF); const int* CNT = (const int*)(F.ws + WS_CNT);
    if (F.wave == 0) {
        const int c = (F.lane < NEXP) ? ((__hip_atomic_load(CNT + (F.lane & 31), __ATOMIC_RELAXED, __HIP_MEMORY_SCOPE_AGENT) + 255) >> 8) : 0;
        int s = c;
#pragma unroll
        for (int o = 1; o < 32; o <<= 1) { const int n = __shfl_up(s, o); if (F.lane >= o) s += n; }
        if (F.lane < NEXP) toff[F.lane] = s - c;
        if (F.lane == NEXP - 1) toff[NEXP] = s;
    }
    __syncthreads();
    if (F.tid < 320) { int e = 0;
#pragma unroll
        for (int s = NEXP / 2; s; s >>= 1) e += (toff[e + s] <= F.tid) ? s : 0;
        ((LAS int*)(F.lds + LDSX_OFF + LX_TEXP))[F.tid] = e; }
    __syncthreads();
}
__device__ __forceinline__ int moe_find_expert(const LAS int* toff, int tile) { return ((const LAS int*)((const LAS unsigned char*)toff + (LX_TEXP - LX_TOFF)))[tile]; }
struct MoeUpOrder {
    static constexpr bool GATHER = true, DEFER = false;
    const char* H2; const char* WGU; const LAS int* toff; const LAS int* rtok; int G, c, nunits;
    __device__ __forceinline__ bool next(int i, pg8::GUnit& u) const {
        const int U = c + G * i; if (i >= MAXU || U >= nunits) return false;
        const int tile = U >> 1, j = U & 1, e = moe_find_expert(toff, tile);
        u.A = H2; u.B = WGU + ((size_t)e * 512 + (size_t)j * 256) * DM; u.pm = tile; u.pn = j; u.aux = i; return true; }
    __device__ __forceinline__ unsigned aoff(const pg8::GUnit& u, int row, int C, int K_) const { const int tok = rtok[u.aux * 256 + row]; return (unsigned)(tok * K_ + C) * 2u; }
};
struct EpiMoeUp {
    static constexpr bool PERM = true, HAS_MID = false;
    half_t* ACT; const LAS float* rrs; const LAS float* rcw; int* trdy;
    __device__ __forceinline__ void mid(f32x4 (&)[2][2][4][2], const pg8::GUnit&, int, int) const {}
    __device__ __forceinline__ void unit_begin(const pg8::GUnit&) const {}
    __device__ __forceinline__ void operator()(const f32x4 (&acc)[2][2][4][2], const pg8::GUnit& u, int wr, int wc, int fr, int fq) const {
        asm volatile("" : "+v"(fr), "+v"(fq));
        const __amdgpu_buffer_rsrc_t rsrc = __builtin_amdgcn_make_buffer_rsrc((void*)ACT, 0, 73728 * DEXP, 0x00020000);
#pragma unroll
        for (int ai = 0; ai < 2; ++ai)
#pragma unroll
            for (int m = 0; m < 4; ++m) { const int rl = ai * 128 + wr * 64 + m * 16 + fr; const float rs = rrs[u.aux * 256 + rl] * (1.0f / 256.0f), cw = rcw[u.aux * 256 + rl] * 8.0f;
                float o[8];
#pragma unroll
                for (int n = 0; n < 2; ++n)
#pragma unroll
                    for (int e = 0; e < 4; ++e) { const float a = acc[ai][0][m][n][e] * rs, up = acc[ai][1][m][n][e] * rs;
                        const float sg = __builtin_amdgcn_rcpf(1.0f + __builtin_amdgcn_exp2f(-a * LOG2E)); o[n * 4 + e] = a * sg * up * cw; }
#pragma unroll
                for (int e = 0; e < 8; ++e) o[e] = __builtin_fminf(__builtin_fmaxf(o[e], -448.f), 448.f);
                int w0 = 0, w1 = 0;
                w0 = __builtin_amdgcn_cvt_pk_fp8_f32(o[0], o[1], w0, false); w0 = __builtin_amdgcn_cvt_pk_fp8_f32(o[2], o[3], w0, true);
                w1 = __builtin_amdgcn_cvt_pk_fp8_f32(o[4], o[5], w1, false); w1 = __builtin_amdgcn_cvt_pk_fp8_f32(o[6], o[7], w1, true);
                __builtin_amdgcn_raw_buffer_store_b64((u32x2){(unsigned)w0, (unsigned)w1}, rsrc, (unsigned)((u.pm * 256 + rl) * DEXP + u.pn * 128 + wc * 32 + 8 * fq), 0, 16); }
        if (trdy) { asm volatile("s_waitcnt vmcnt(0)" ::: "memory");
        if ((threadIdx.x & 63) == 0) __hip_atomic_fetch_add(trdy + u.pm, 1, __ATOMIC_RELAXED, __HIP_MEMORY_SCOPE_AGENT); }
    }
};
struct MoeDownOrder {
    static constexpr bool GATHER = false, DEFER = true;
    const char* ACT; const char* WDT; const LAS int* toff; int* q6; int* trdy; volatile LAS int* slot; int nunits; mutable int tA, tB, tC, fA, fB;
    __device__ __forceinline__ int draw() const { return __hip_atomic_fetch_add(q6, 1, __ATOMIC_RELAXED, __HIP_MEMORY_SCOPE_AGENT); }
    __device__ __forceinline__ int flag(int U) const { return __hip_atomic_load(trdy + (U >> 2), __ATOMIC_RELAXED, __HIP_MEMORY_SCOPE_AGENT); }
    __device__ __forceinline__ void prefetch(int i) const {
        if (threadIdx.x == 0) {
            if (i > 1) { tA = tB; tB = tC; fA = fB; }
            tC = draw();
            fB = flag(tB);
        }
    }
    __device__ __forceinline__ bool next(int i, pg8::GUnit& u) const {
        if (threadIdx.x == 0) {
            int U, fl;
            if (i == 0) { U = draw(); tA = draw(); tB = draw(); fl = 0; fA = flag(tA); } else { U = tA; fl = fA; }
            if (U < nunits && fl < 16) { int* w = trdy + (U >> 2); unsigned sp = 0;
                while (__hip_atomic_load(w, __ATOMIC_RELAXED, __HIP_MEMORY_SCOPE_AGENT) < 16) { __builtin_amdgcn_s_sleep(2); if (++sp > (1u << 22)) break; }
            }
            slot[i & 1] = U;
        }
        asm volatile("s_waitcnt lgkmcnt(0)" ::: "memory"); __builtin_amdgcn_s_barrier(); asm volatile("" ::: "memory");
        const int U = slot[i & 1]; if (U >= nunits) return false;
        const int tile = U >> 2, pn = U & 3, e = moe_find_expert(toff, tile);
        u.A = ACT + (size_t)tile * 256 * DEXP; u.B = WDT + ((size_t)e * DM + (size_t)pn * 256) * DEXP; u.pm = tile; u.pn = pn; u.aux = 0; return true; }
    __device__ __forceinline__ unsigned aoff(const pg8::GUnit&, int row, int C, int K_) const { return (unsigned)(row * K_ + C) * 2u; }
};
struct EpiMoeDown {
    static constexpr int PERM = 2; static constexpr bool HAS_MID = false;
    half_t* Y;
    __device__ __forceinline__ void mid(f32x4 (&)[2][2][4][2], const pg8::GUnit&, int, int) const {}
    __device__ __forceinline__ void unit_begin(const pg8::GUnit&) const {}
    __device__ __forceinline__ void operator()(const f32x4 (&acc)[2][2][4][2], const pg8::GUnit& u, int wr, int wc, int fr, int fq) const {
        asm volatile("" : "+v"(fr), "+v"(fq));
        if (!Y) return;
#pragma unroll
        for (int ai = 0; ai < 2; ++ai)
#pragma unroll
            for (int m = 0; m < 4; ++m) { unsigned char* rowp = (unsigned char*)Y + ((size_t)u.pm * 256 + ai * 128 + wr * 64 + m * 16 + fr) * DM + u.pn * 256 + wc * 64 + 16 * fq;
                int w[4];
#pragma unroll
                for (int bj = 0; bj < 2; ++bj) { const f32x4 v0 = acc[ai][bj][m][0] * 0.0625f, v1 = acc[ai][bj][m][1] * 0.0625f;
                    int w0 = 0, w1 = 0;
                    w0 = __builtin_amdgcn_cvt_pk_fp8_f32(v0[0], v0[1], w0, false); w0 = __builtin_amdgcn_cvt_pk_fp8_f32(v0[2], v0[3], w0, true);
                    w1 = __builtin_amdgcn_cvt_pk_fp8_f32(v1[0], v1[1], w1, false); w1 = __builtin_amdgcn_cvt_pk_fp8_f32(v1[2], v1[3], w1, true);
                    w[2 * bj] = w0; w[2 * bj + 1] = w1; }
                *(u32x4*)rowp = (u32x4){(unsigned)w[0], (unsigned)w[1], (unsigned)w[2], (unsigned)w[3]}; }
    }
};

__device__ __forceinline__ void p7_final(Frame& F) {
    const LAS int* toff = (const LAS int*)(F.lds + LDSX_OFF + LX_TOFF);
    const TokInfo* TOK = (const TokInfo*)(F.ws + WS_TOK); const half_t* Y = (const half_t*)(F.ws + WS_Y); const half_t* H2 = (const half_t*)(F.ws + WS_XH);
    const int gw = F.vcu * NWAVES + F.wave, NGW = F.G * NWAVES;
    f32x4 g[4];
#pragma unroll
    for (int j = 0; j < 2; ++j) { g[2 * j] = *(const GAS f32x4*)(F.gfin + 8 * (F.lane + 64 * j)); g[2 * j + 1] = *(const GAS f32x4*)(F.gfin + 8 * (F.lane + 64 * j) + 4); }
    for (int m0 = gw; m0 < T; m0 += 16 * NGW) {
        int r1l = 0, r2l = 0;
        { const int mi = m0 + (F.lane & 15) * NGW; if (mi < T) { const TokInfo ti = TOK[mi]; r1l = toff[ti.e1] * 256 + ti.pad0; r2l = toff[ti.e2] * 256 + ti.pad1; } }
#pragma unroll 1
        for (int i = 0; i < 16; i += 4) {
            int mr[4]; size_t y1[4], y2[4]; bool ok[4];
#pragma unroll
            for (int r = 0; r < 4; ++r) { mr[r] = m0 + (i + r) * NGW; ok[r] = mr[r] < T; if (!ok[r]) mr[r] = m0;
                y1[r] = (size_t)__builtin_amdgcn_readlane(r1l, i + r); y2[r] = (size_t)__builtin_amdgcn_readlane(r2l, i + r); if (!ok[r]) { y1[r] = y1[0]; y2[r] = y2[0]; } }
            if (!ok[0]) break;
            h8 xv[4][2]; u32x2 yv[4][2], zv[4][2];
#pragma unroll
            for (int r = 0; r < 4; ++r)
#pragma unroll
                for (int j = 0; j < 2; ++j) { const int c = 8 * (F.lane + 64 * j);
                    xv[r][j] = __builtin_nontemporal_load((const GAS h8*)(H2 + (size_t)mr[r] * DM + c)); yv[r][j] = __builtin_nontemporal_load((const GAS u32x2*)((const unsigned char*)Y + y1[r] * DM + c)); zv[r][j] = __builtin_nontemporal_load((const GAS u32x2*)((const unsigned char*)Y + y2[r] * DM + c)); }
#pragma unroll
            for (int r = 0; r < 4; ++r) {
                float v[16]; float sq = 0.f;
#pragma unroll
                for (int j = 0; j < 2; ++j)
                    { const f32x2 y0 = __builtin_amdgcn_cvt_pk_f32_fp8((int)yv[r][j][0], false), y1_ = __builtin_amdgcn_cvt_pk_f32_fp8((int)yv[r][j][0], true), y2_ = __builtin_amdgcn_cvt_pk_f32_fp8((int)yv[r][j][1], false), y3 = __builtin_amdgcn_cvt_pk_f32_fp8((int)yv[r][j][1], true);
                      const f32x2 z0 = __builtin_amdgcn_cvt_pk_f32_fp8((int)zv[r][j][0], false), z1_ = __builtin_amdgcn_cvt_pk_f32_fp8((int)zv[r][j][0], true), z2_ = __builtin_amdgcn_cvt_pk_f32_fp8((int)zv[r][j][1], false), z3 = __builtin_amdgcn_cvt_pk_f32_fp8((int)zv[r][j][1], true);
                      const float yz[8] = {y0[0] + z0[0], y0[1] + z0[1], y1_[0] + z1_[0], y1_[1] + z1_[1], y2_[0] + z2_[0], y2_[1] + z2_[1], y3[0] + z3[0], y3[1] + z3[1]};
#pragma unroll
                      for (int e = 0; e < 8; ++e) { const float t = (float)xv[r][j][e] + yz[e] * 0.0625f; v[8 * j + e] = t; sq += t * t; } }
                sq = wave_sum(sq);
                const float rr = 1.0f / sqrtf(sq * (1.0f / DM) + EPS);
                if (ok[r]) {
#pragma unroll
                    for (int j = 0; j < 2; ++j) { const int c = 8 * (F.lane + 64 * j);
                        __builtin_nontemporal_store((f32x4){v[8 * j] * rr, v[8 * j + 1] * rr, v[8 * j + 2] * rr, v[8 * j + 3] * rr} * g[2 * j], (GAS f32x4*)(F.out + (size_t)mr[r] * DM + c));
                        __builtin_nontemporal_store((f32x4){v[8 * j + 4] * rr, v[8 * j + 5] * rr, v[8 * j + 6] * rr, v[8 * j + 7] * rr} * g[2 * j + 1], (GAS f32x4*)(F.out + (size_t)mr[r] * DM + c + 4)); } }
            }
        }
    }
}

#define XB_TMO      128
#define XB_XCNT(j)  (256  + 64 * (j))
#define XB_XSUB(j)  (1280 + 64 * (j))
#define XB_XGEN(j)  (2304 + 64 * (j))
#define XB_TOP      3328
#define XB_TOPGEN   3392
#define XCD_BAR_WORDS 3456
#define XB_SPIN_CAP (1u << 18)
__device__ __forceinline__ unsigned xb_ld(unsigned* p)              { return __hip_atomic_load(p, __ATOMIC_RELAXED, __HIP_MEMORY_SCOPE_AGENT); }
__device__ __forceinline__ unsigned xb_add(unsigned* p, unsigned v) { return __hip_atomic_fetch_add(p, v, __ATOMIC_RELAXED, __HIP_MEMORY_SCOPE_AGENT); }
__device__ __forceinline__ unsigned xb_xcc_id() { return (unsigned)__builtin_amdgcn_s_getreg((3 << 11) | 20) & 0xFu; }
#define XB_SPIN(cond, bar) do { unsigned _sp = 0; while (cond) { __builtin_amdgcn_s_sleep(1); \
    if ((++_sp & 255u) == 0u) { if (xb_ld(&(bar)[XB_TMO])) break; if (_sp > XB_SPIN_CAP) { atomicAdd(&(bar)[XB_TMO], 1u); break; } } } } while (0)
struct XcdBarrier { unsigned* bar; unsigned x; volatile LAS unsigned* st; };
__device__ __forceinline__ XcdBarrier xcd_barrier_post(unsigned* bar, volatile LAS unsigned* st) {
    XcdBarrier b; b.bar = bar; b.x = xb_xcc_id(); b.st = st;
    if (threadIdx.x == 0) (void)xb_add(&bar[XB_XCNT(b.x)], 1u);
    return b;
}
__device__ __forceinline__ void xcd_barrier_complete(unsigned* bar, unsigned x, unsigned& nloc, unsigned& nx) {
    const unsigned G = gridDim.x * gridDim.y * gridDim.z;
    unsigned sum, cnt, mine, sp = 0u;
    for (;;) {
        sum = 0u; cnt = 0u; mine = 0u;
#pragma unroll
        for (unsigned j = 0; j < 16; ++j) { const unsigned c = xb_ld(&bar[XB_XCNT(j)]); sum += c; cnt += (c > 0u) ? 1u : 0u; mine = (j == x) ? c : mine; }
        if (sum == G) break;
        __builtin_amdgcn_s_sleep(1);
        if ((++sp & 255u) == 0u) { if (xb_ld(&bar[XB_TMO])) break; if (sp > XB_SPIN_CAP) { atomicAdd(&bar[XB_TMO], 1u); break; } }
    }
    nloc = mine > 0u ? mine : 1u; nx = cnt > 0u ? cnt : 1u;
}
__device__ __forceinline__ void xcd_barrier(const XcdBarrier& b) {
    asm volatile("s_waitcnt vmcnt(0)" ::: "memory");
    __syncthreads();
    if (threadIdx.x == 0) {
        unsigned* bar = b.bar;
        __builtin_amdgcn_s_waitcnt(0);
        unsigned nloc = b.st[0], nx = b.st[1];
        if (nloc == 0u) { xcd_barrier_complete(bar, b.x, nloc, nx); b.st[0] = nloc; b.st[1] = nx; }
        const unsigned old = xb_add(&bar[XB_XSUB(b.x)], 1u);
        const unsigned gen = old / nloc;
        if (old + 1u == (gen + 1u) * nloc) {
            __builtin_amdgcn_fence(__ATOMIC_RELEASE, "agent");
            asm volatile("s_waitcnt vmcnt(0)" ::: "memory");
            const unsigned og = xb_add(&bar[XB_TOP], 1u);
            const unsigned tg = og / nx;
            if (og + 1u == (tg + 1u) * nx) xb_add(&bar[XB_TOPGEN], 1u);
            else XB_SPIN(xb_ld(&bar[XB_TOPGEN]) == tg, bar);
            __builtin_amdgcn_fence(__ATOMIC_ACQUIRE, "agent");
            xb_add(&bar[XB_XGEN(b.x)], 1u);
            asm volatile("s_waitcnt vmcnt(0)" ::: "memory");
        } else {
            XB_SPIN(xb_ld(&bar[XB_XGEN(b.x)]) == gen, bar);
            __builtin_amdgcn_fence(__ATOMIC_ACQUIRE, "agent");
            asm volatile("s_waitcnt vmcnt(0)" ::: "memory");
        }
    }
    __syncthreads();
}

__global__ void __launch_bounds__(NWAVES * 64, 2) fwd_mega(Args args) {
    extern __shared__ __attribute__((aligned(16))) unsigned char lds[];
    Frame F;
    F.lds = (LAS unsigned char*)lds; F.tid = threadIdx.x; F.lane = F.tid & 63; F.wave = __builtin_amdgcn_readfirstlane(F.tid >> 6);
    F.G = gridDim.x; { const int bx = blockIdx.x; F.vcu = (F.G % 8 == 0) ? (bx % 8) * (F.G / 8) + bx / 8 : bx; }
    F.x = args.in[0]; F.norm_mix_g = args.in[1]; F.w_in = args.in[2]; F.b_forget = args.in[3]; F.fox_g = args.in[4]; F.moba_g = args.in[5]; F.w_out = args.in[6]; F.norm_ffn_g = args.in[7];
    F.wrg = args.in[8]; F.brg = args.in[9]; F.wre = args.in[10]; F.bre = args.in[11]; F.wg = args.in[12]; F.wu = args.in[13]; F.wd = args.in[14]; F.gfin = args.in[15];
    F.out = args.out; F.ws = args.ws;
    unsigned char* ws = args.ws;
    if (F.tid < 16) ((LAS unsigned*)(F.lds + LDSX_OFF))[F.tid] = 0u;
    __syncthreads();
    XcdBarrier xbar = xcd_barrier_post((unsigned*)(ws + WS_CTL) + args.li * XCD_BAR_WORDS, (volatile LAS unsigned*)(F.lds + LDSX_OFF + 32));
    const int lo = args.ph_lo, hi = args.ph_hi;
#ifndef PROBE_MOBA
#define PROBE_MOBA 0
#endif
#ifndef MOBA_SPARSE_UNUSED
#define MOBA_SPARSE_UNUSED 1
#endif
#ifndef PHMASK
#define PHMASK 0xFF
#endif
#define IN(k) ((((PHMASK) >> (k)) & 1) && lo <= (k) && (k) < hi)
#define SEAM(k) do { if (IN(k) && IN((k) + 1)) xcd_barrier(xbar); } while (0)
#ifndef REPMASK
#define REPMASK 0x00
#endif
#define REP(k) for (int rep_ = 0; rep_ < 1 + (((REPMASK) >> (k)) & 1); ++rep_)
    half_t* QKV = (half_t*)(ws + WS_QKV); half_t* OB = (half_t*)(ws + WS_O);
    constexpr size_t KIND = (size_t)BATCH * NH * SEQ * HD;

    if (IN(0)) { REP(0) p0_prep(F, args); SEAM(0); }

    if (IN(1)) { REP(1) {
        if (F.vcu < 8) { const int seq = F.vcu * 8 + F.wave; cumsum_seq((const float*)(ws + WS_LOGF) + (size_t)seq * SEQ, (float*)(ws + WS_CB) + (size_t)seq * SEQ, F.lane); }
        pg8::DenseOrder S; S.init(ws + WS_XH, ws + WS_W1T, T, NQKV, DM, F.G, (int)blockIdx.x);
        EpiQKV E{QKV, (const float*)(ws + WS_RSTD1), (const float2*)(ws + WS_ROPE), (float*)(ws + WS_KSUM), (unsigned*)(ws + WS_NRM)};
        pg8::gemm_phase<EpiQKV, pg8::DenseOrder, true>(F.lds, DM, S, E); }
        SEAM(1);
    }

    if (IN(2)) {
        const float* CB = (const float*)(ws + WS_CB); const float* KSUM = (const float*)(ws + WS_KSUM); float* SSQ = (float*)(ws + WS_SSQ); const float* NRM = (const float*)(ws + WS_NRM);
        const int bh = F.vcu >> 2, c4 = F.vcu & 3, b = bh >> 3, h = bh & 7;
#if MOBA_SPARSE
        att::moba_gate(QKV, KSUM, (int*)(ws + WS_CNTQ), (int*)(ws + WS_LQ), F.vcu * 512 + F.tid, F.G * 512, F.lane);
#if PROBE_MOBA == 1
        att::moba_gate(QKV, KSUM, (int*)(ws + WS_CNTQ) + 1024, (int*)(ws + WS_PO), F.vcu * 512 + F.tid, F.G * 512, F.lane);
#endif
        xcd_barrier(xbar);
#endif
        if (bh < BATCH * NH) att::head_tables(b, h, KSUM, (char*)lds, F.tid);
#if MOBA_SPARSE
        if (bh < BATCH * NH) { int s0 = 0;
            for (int i = 0; i < 4; ++i) { const int qb = (i == 0) ? c4 : (i == 1) ? 7 - c4 : (i == 2) ? 8 + c4 : 15 - c4;
                s0 = att::attn_unit<true, 8>(b, h, qb, 4 * qb + 4, QKV, QKV + 512, QKV + 1024, OB, CB, KSUM, NRM, SSQ, (char*)lds, 0, false, att::AttNext{nullptr, nullptr, 0, 0, 0, 0}, (int*)(ws + WS_PRDY)); } (void)s0; }
#else
        if (bh < BATCH * NH) {
            int* fqc = (int*)(ws + WS_PRDY) + 150; volatile LAS int* fslot = (volatile LAS int*)(F.lds + LDSX_OFF + 56); int npull = 0;
#define FOX_PULL(dst) do { if (F.tid == 0) fslot[npull & 1] = __hip_atomic_fetch_add(fqc, 1, __ATOMIC_RELAXED, __HIP_MEMORY_SCOPE_AGENT); \
            asm volatile("s_waitcnt lgkmcnt(0)" ::: "memory"); __builtin_amdgcn_s_barrier(); asm volatile("" ::: "memory"); dst = fslot[npull & 1]; ++npull; } while (0)
            int fu; FOX_PULL(fu);
            int s0 = 0; bool pre = false;
            for (int i = 0; i < 4; ++i) {
                const int qb = (i == 0) ? 15 - c4 : (i == 1) ? 8 + c4 : (i == 2) ? 7 - c4 : c4, qb1 = (i == 0) ? 8 + c4 : (i == 1) ? 7 - c4 : c4;
                const att::AttNext nx = (i < 3) ? att::AttNext{QKV + 4 * KIND, QKV + 5 * KIND, b, h, qb1, 1} : att::AttNext{QKV + 1 * KIND, QKV + 2 * KIND, (fu & 63) >> 3, fu & 7, 15 - (fu >> 6), fu < 1024 ? 1 : 0};
                s0 = att::attn_unit<false, 8>(b, h, qb, 4 * qb + 4, QKV + 3 * KIND, QKV + 4 * KIND, QKV + 5 * KIND, OB + 512, CB, KSUM, NRM, SSQ + 8, (char*)lds, s0, pre, nx, (int*)(ws + WS_PRDY));
                pre = true; }
            while (fu < 1024) {
                int fn; FOX_PULL(fn);
                const att::AttNext nx{QKV + 1 * KIND, QKV + 2 * KIND, (fn & 63) >> 3, fn & 7, 15 - (fn >> 6), fn < 1024 ? 1 : 0};
                const int qb = 15 - (fu >> 6);
                s0 = att::attn_unit<true, 8>((fu & 63) >> 3, fu & 7, qb, 4 * qb + 4, QKV, QKV + 1 * KIND, QKV + 2 * KIND, OB, CB, KSUM, NRM, SSQ, (char*)lds, s0, pre, nx, (int*)(ws + WS_PRDY));
                fu = fn; }
#undef FOX_PULL
        }
#endif
    }

    if (IN(3)) {
        if (blockIdx.x == 0 && F.tid < NEXP) ((int*)(ws + WS_CNT))[F.tid] = 0;
        if (blockIdx.x == 0) { ((int*)(ws + WS_TRDY))[F.tid] = 0; ((int*)(ws + WS_TRDY))[512 + F.tid] = 0; }
        OutOrder S{(const char*)(ws + WS_O), (const char*)(ws + WS_WOT), (int*)(ws + WS_PRDY) + 140, (int*)(ws + WS_PRDY), (volatile LAS int*)(F.lds + LDSX_OFF + 48), 0};
        EpiOut E{F.x, (half_t*)(ws + WS_XH), (const float*)(ws + WS_SSQ), (LAS f32x2*)(F.lds + LDSX_OFF + LX_RTOK), ws + WS_H8};
        pg8::gemm_phase<EpiOut, OutOrder, true>(F.lds, DM, S, E);
        SEAM(3);
    }

    if (IN(4)) { p4_router(F); SEAM(4); }

#ifndef PROBE_MOE_REP
#define PROBE_MOE_REP 1
#endif
_Pragma("unroll")
    for (int mrep_ = 0; mrep_ < PROBE_MOE_REP; ++mrep_) {
#ifndef PROBE_UP_REP
#define PROBE_UP_REP 1
#endif
_Pragma("unroll")
    for (int urep_ = 0; urep_ < PROBE_UP_REP; ++urep_)
    if (IN(5)) {
        moe_tile_table(F);
        const LAS int* toff = (const LAS int*)(F.lds + LDSX_OFF + LX_TOFF);
        LAS int* rtok = (LAS int*)(F.lds + LDSX_OFF + LX_RTOK); LAS float* rrs = (LAS float*)(F.lds + LDSX_OFF + LX_RRS); LAS float* rcw = (LAS float*)(F.lds + LDSX_OFF + LX_RCW);
        const int nunits = toff[NEXP] * 2;
        const int* CNT = (const int*)(ws + WS_CNT); const int* LTOK = (const int*)(ws + WS_LTOK); const float* LRS = (const float*)(ws + WS_LRS); const float* LCW = (const float*)(ws + WS_LCW);
        for (int i = 0; i < MAXU; ++i) { const int U = F.vcu + F.G * i;
            if (U < nunits && F.tid < 256) { const int tile = U >> 1, e = moe_find_expert(toff, tile), idx = (tile - toff[e]) * 256 + F.tid; const bool ok = idx < __hip_atomic_load(CNT + e, __ATOMIC_RELAXED, __HIP_MEMORY_SCOPE_AGENT);
                rtok[i * 256 + F.tid] = ok ? LTOK[(size_t)e * T + idx] : 0; rrs[i * 256 + F.tid] = ok ? LRS[(size_t)e * T + idx] : 0.f; rcw[i * 256 + F.tid] = ok ? LCW[(size_t)e * T + idx] : 0.f; } }
        __syncthreads();
        MoeUpOrder S{(const char*)(ws + WS_H8), (const char*)(ws + WS_WGU), toff, rtok, F.G, F.vcu, nunits};
        EpiMoeUp E{(half_t*)(ws + WS_ACT), rrs, rcw, urep_ == PROBE_UP_REP - 1 ? (int*)(ws + WS_TRDY) : nullptr};
        pg8::gemm_phase<EpiMoeUp, MoeUpOrder, true, true>(F.lds, DM / 2, S, E);
    }

#ifndef PROBE_DN_REP
#define PROBE_DN_REP 1
#endif
_Pragma("unroll")
    for (int drep_ = 0; drep_ < PROBE_DN_REP; ++drep_)
    if (IN(6)) {
        if (drep_) xcd_barrier(xbar);
        if (!IN(5)) moe_tile_table(F);
        const LAS int* toff = (const LAS int*)(F.lds + LDSX_OFF + LX_TOFF);
        MoeDownOrder S{(const char*)(ws + WS_ACT), (const char*)(ws + WS_WD), toff, (int*)(ws + WS_TRDY) + 512 + mrep_ + drep_, (int*)(ws + WS_TRDY), (volatile LAS int*)(F.lds + LDSX_OFF + 40), toff[NEXP] * 4, 0, 0, 0, 0, 0};
        EpiMoeDown E{drep_ == PROBE_DN_REP - 1 ? (half_t*)(ws + WS_Y) : nullptr};
        pg8::gemm_phase<EpiMoeDown, MoeDownOrder, true, true>(F.lds, DEXP / 2, S, E);
        if (drep_ == PROBE_DN_REP - 1) { if (mrep_ == PROBE_MOE_REP - 1) SEAM(6); else xcd_barrier(xbar); }
    }
    }

#ifdef PROBE_SYNCS
    if (IN(7)) { for (int i_ = 0; i_ < PROBE_SYNCS; ++i_) xcd_barrier(xbar); }
#endif
    if (IN(7)) { if (!IN(5) && !IN(6)) moe_tile_table(F); p7_final(F); }
#undef IN
#undef SEAM
}

__device__ __forceinline__ void nk_toff(const int* CNT, int* toff) { int a = 0; for (int e = 0; e < NEXP; ++e) { toff[e] = a; a += (CNT[e] + 255) >> 8; } toff[NEXP] = a; }
__global__ void __launch_bounds__(256) nk_moe_up(const half_t* __restrict__ H2, const float* __restrict__ g, const float* __restrict__ wg, const float* __restrict__ wu,
                                                  const int* CNT, const int* LTOK, const float* LRS, const float* LCW, half_t* ACT) {
    __shared__ int toff[NEXP + 1]; __shared__ float hs[DM];
    const int tid = threadIdx.x, row = blockIdx.x;
    if (tid == 0) nk_toff(CNT, toff);
    __syncthreads();
    const int tile = row >> 8; if (tile >= toff[NEXP]) return;
    int e = 0; for (int k = 1; k < NEXP; ++k) if (toff[k] <= tile) e = k;
    const int idx = (tile - toff[e]) * 256 + (row & 255);
    if (idx >= CNT[e]) { ACT[(size_t)row * DEXP + tid] = (half_t)0.f; return; }
    const int tok = LTOK[(size_t)e * T + idx]; const float rs = LRS[(size_t)e * T + idx], cw = LCW[(size_t)e * T + idx];
    for (int k = tid; k < DM; k += 256) hs[k] = (float)H2[(size_t)tok * DM + k] * g[k];
    __syncthreads();
    const float* pg = wg + (size_t)e * DM * DEXP + tid; const float* pu = wu + (size_t)e * DM * DEXP + tid;
    float a = 0.f, u = 0.f;
    for (int k = 0; k < DM; ++k) { a += hs[k] * pg[(size_t)k * DEXP]; u += hs[k] * pu[(size_t)k * DEXP]; }
    a *= rs; u *= rs;
    ACT[(size_t)row * DEXP + tid] = (half_t)(a / (1.0f + expf(-a)) * u * cw);
}
__global__ void __launch_bounds__(256) nk_moe_down(const half_t* __restrict__ ACT, const float* __restrict__ wd, const int* CNT, half_t* Y) {
    __shared__ int toff[NEXP + 1]; __shared__ float as[DEXP];
    const int tid = threadIdx.x, row = blockIdx.x;
    if (tid == 0) nk_toff(CNT, toff);
    __syncthreads();
    const int tile = row >> 8; if (tile >= toff[NEXP]) return;
    int e = 0; for (int k = 1; k < NEXP; ++k) if (toff[k] <= tile) e = k;
    as[tid] = (float)ACT[(size_t)row * DEXP + tid];
    __syncthreads();
    const float* pd = wd + (size_t)e * DEXP * DM;
    float y[4] = {0.f, 0.f, 0.f, 0.f};
    for (int f = 0; f < DEXP; ++f) { const float av = as[f];
#pragma unroll
        for (int j = 0; j < 4; ++j) y[j] += av * pd[(size_t)f * DM + tid + 256 * j]; }
#pragma unroll
    for (int j = 0; j < 4; ++j) Y[(size_t)row * DM + tid + 256 * j] = (half_t)y[j];
}
__global__ void __launch_bounds__(256) nk_moe_final(const TokInfo* __restrict__ tok, const int* CNT, const half_t* __restrict__ Y, const float* __restrict__ gfin, float* out) {
    __shared__ int toff[NEXP + 1]; __shared__ float red[4];
    const int tid = threadIdx.x, lane = tid & 63, wid = tid >> 6, row = blockIdx.x;
    if (tid == 0) nk_toff(CNT, toff);
    __syncthreads();
    const TokInfo ti = tok[row];
    const size_t r1 = (size_t)toff[ti.e1] * 256 + ti.pad0, r2 = (size_t)toff[ti.e2] * 256 + ti.pad1;
    float y[4]; float ss = 0.f;
#pragma unroll
    for (int j = 0; j < 4; ++j) { const int k = tid + 256 * j; y[j] = out[(size_t)row * DM + k] + (float)Y[r1 * DM + k] + (float)Y[r2 * DM + k]; ss += y[j] * y[j]; }
    ss = wave_sum(ss); if (lane == 0) red[wid] = ss;
    __syncthreads();
    const float rs = 1.0f / sqrtf((red[0] + red[1] + red[2] + red[3]) * (1.0f / DM) + EPS);
#pragma unroll
    for (int j = 0; j < 4; ++j) { const int k = tid + 256 * j; out[(size_t)row * DM + k] = y[j] * rs * gfin[k]; }
}

#ifndef SPLITMASK
#define SPLITMASK 0x00
#endif
#ifndef OPTMASK
#define OPTMASK 0xFF
#endif
extern "C" void kernel_launch(void* const* d_in, const int* in_sizes, int n_in, void* d_out, int out_size, void* d_ws, size_t ws_size, hipStream_t stream) {
    if (n_in != 16 || ws_size < WS_END2 || out_size != T * DM) { fprintf(stderr, "kernel_launch: unexpected n_in %d / ws %zu / out %d\n", n_in, ws_size, out_size); return; }
    const float* x = (const float*)d_in[0]; const float* norm_mix_g = (const float*)d_in[1]; const float* w_in = (const float*)d_in[2];
    const float* b_forget = (const float*)d_in[3]; const float* fox_g = (const float*)d_in[4]; const float* moba_g = (const float*)d_in[5];
    const float* w_out = (const float*)d_in[6]; const float* norm_ffn_g = (const float*)d_in[7]; const float* wrg = (const float*)d_in[8];
    const float* brg = (const float*)d_in[9]; const float* wre = (const float*)d_in[10]; const float* bre = (const float*)d_in[11];
    const float* wg = (const float*)d_in[12]; const float* wu = (const float*)d_in[13]; const float* wd = (const float*)d_in[14];
    const float* gfin = (const float*)d_in[15];
    float* out = (float*)d_out; unsigned char* ws = (unsigned char*)d_ws;
    half_t* QKV = (half_t*)(ws + WS_QKV); half_t* OB = (half_t*)(ws + WS_O);
    float* RSTD1 = (float*)(ws + WS_RSTD1); float* LOGF = (float*)(ws + WS_LOGF); float* CB = (float*)(ws + WS_CB);
    float* KSUM = (float*)(ws + WS_KSUM); float* SSQ = (float*)(ws + WS_SSQ); TokInfo* TOK = (TokInfo*)(ws + WS_TOK); float2* ROPE = (float2*)(ws + WS_ROPE);

    static int grid = 0;
    if (grid == 0) {
        int dev = 0, cus = 0, per_cu = 0;
        hipGetDevice(&dev); hipDeviceGetAttribute(&cus, hipDeviceAttributeMultiprocessorCount, dev);
        if (hipFuncSetAttribute((const void*)fwd_mega, hipFuncAttributeMaxDynamicSharedMemorySize, LDS_BYTES) != hipSuccess) { fprintf(stderr, "kernel_launch: hipFuncSetAttribute failed\n"); grid = -1; return; }
        if (hipOccupancyMaxActiveBlocksPerMultiprocessor(&per_cu, (const void*)fwd_mega, NWAVES * 64, LDS_BYTES) != hipSuccess || per_cu < 1) { fprintf(stderr, "kernel_launch: occupancy query says %d\n", per_cu); per_cu = 1; }
        (void)hipGetLastError();
        grid = cus;
        if (grid != 256) fprintf(stderr, "kernel_launch: %d CUs (built for 256)\n", grid);
    }
    if (grid < 0) return;
    Args a{};
    for (int i = 0; i < 16; ++i) a.in[i] = (const float*)d_in[i];
    a.out = out; a.ws = ws;
    for (int i = 0; i < 8; ++i) a.inv_freq[i] = pow(500000.0, -(double)i / 8.0);
    RopeArgs ra{}; for (int i = 0; i < 8; ++i) ra.inv_freq[i] = a.inv_freq[i];
    unsigned mask = OPTMASK; if (mask) mask |= 1u;
    if (hipMemsetAsync(ws + WS_CTL, 0, 8 * XCD_BAR_WORDS * 4, stream) != hipSuccess) { fprintf(stderr, "kernel_launch: memset of the barrier words failed\n"); return; }
    int n_launch = 0;
    auto launch_opt = [&](int lo, int hi) { a.ph_lo = lo; a.ph_hi = hi; a.li = n_launch++; a.pad = 0;
        hipLaunchKernelGGL(fwd_mega, dim3(grid), dim3(NWAVES * 64), LDS_BYTES, stream, a);
        const hipError_t e = hipPeekAtLastError();
        if (e != hipSuccess) fprintf(stderr, "kernel_launch: launch [%d,%d) failed: %s\n", lo, hi, hipGetErrorString(e)); };
#ifdef PROBE_DUP
    launch_opt(0, PROBE_DUP + 1); launch_opt(PROBE_DLO, PROBE_DUP + 1); if (PROBE_DUP + 1 < NPHASE) launch_opt(PROBE_DUP + 1, NPHASE);
    return;
#endif
    int p = 0;
    while (p < NPHASE) {
        if ((mask >> p) & 1u) { int q = p; while (q < NPHASE && ((mask >> q) & 1u) && !(q > p && ((SPLITMASK >> q) & 1u))) ++q; launch_opt(p, q);
            if (p == 0 && !(OPTMASK & 1u)) { nk_rope<<<SEQ * 8 / 256, 256, 0, stream>>>(ROPE, ra); nk_rowstats<<<T, 256, 0, stream>>>(x, norm_mix_g, w_in, b_forget, RSTD1, LOGF); }
            p = q; continue; }
        switch (p) {
        case 0: nk_rope<<<SEQ * 8 / 256, 256, 0, stream>>>(ROPE, ra); nk_rowstats<<<T, 256, 0, stream>>>(x, norm_mix_g, w_in, b_forget, RSTD1, LOGF); break;
        case 1: nk_cumsum<<<1, 64, 0, stream>>>(LOGF, CB);
                nk_gemm<<<dim3(NQKV / 64, T / 64), 256, 0, stream>>>(DM, InA{x, norm_mix_g}, InB{w_in}, InS{RSTD1, QKV});
                nk_rotary<<<(unsigned)(((size_t)T * 128 + 255) / 256), 256, 0, stream>>>(QKV, ROPE);
                nk_ksum<<<dim3(BATCH * 16, 2), 256, 0, stream>>>(QKV, KSUM); break;
        case 2: nk_attn<true><<<T * 8 / 4, 256, 0, stream>>>(QKV, CB, KSUM, OB, SSQ); nk_attn<false><<<T * 8 / 4, 256, 0, stream>>>(QKV, CB, KSUM, OB, SSQ); break;
        case 3: nk_gemm<<<dim3(DM / 64, T / 64), 256, 0, stream>>>(DM, OutA{OB, SSQ, fox_g, moba_g}, OutB{w_out}, OutS{x, out}); break;
        case 4: nk_router<<<T, 256, 0, stream>>>(out, norm_ffn_g, wrg, brg, wre, bre, TOK); break;
        case 5: if (!((mask >> 4) & 1u)) { nk_moe<<<T, 256, 0, stream>>>(out, norm_ffn_g, TOK, wg, wu, wd, gfin, out); p = NPHASE; }
                else nk_moe_up<<<73728, 256, 0, stream>>>((const half_t*)(ws + WS_XH), norm_ffn_g, wg, wu, (const int*)(ws + WS_CNT), (const int*)(ws + WS_LTOK), (const float*)(ws + WS_LRS), (const float*)(ws + WS_LCW), (half_t*)(ws + WS_ACT));
                break;
        case 6: nk_moe_down<<<73728, 256, 0, stream>>>((const half_t*)(ws + WS_ACT), wd, (const int*)(ws + WS_CNT), (half_t*)(ws + WS_Y)); break;
        case 7: nk_moe_final<<<T, 256, 0, stream>>>(TOK, (const int*)(ws + WS_CNT), (const half_t*)(ws + WS_Y), gfin, out); break;
        default: break;
        }
        ++p;
    }
}
```

```cpp
#include <hip/hip_runtime.h>
#include <cstdio>
#include <cstdint>
#include <cmath>

constexpr int BATCH = 8, SEQ = 4096, DM = 1024, T = BATCH * SEQ;
constexpr int HD = 64, NH = 8;
constexpr int NQKV = 3072;
constexpr int INC = 3080;
constexpr int NBLK = 16, MBLK = 256;
constexpr int NEXP = 32, NGRP = 4, EPG = 8, DEXP = 256;
constexpr float EPS = 1e-6f;
constexpr float C2 = 0.125f * 1.4426950408889634f;
constexpr float LOG2E = 1.4426950408889634f;

typedef _Float16 half_t;
typedef _Float16 h8 __attribute__((ext_vector_type(8)));
typedef float f32x4 __attribute__((ext_vector_type(4)));

constexpr size_t MiB = 1u << 20;
constexpr size_t WS_CTL = 0;
constexpr size_t WS_QKV = 64 * MiB;
constexpr size_t WS_O = 320 * MiB;
constexpr size_t WS_MISC = 384 * MiB;
constexpr size_t WS_RSTD1 = WS_MISC;
constexpr size_t WS_LOGF = WS_MISC + 1 * MiB;
constexpr size_t WS_CB = WS_MISC + 2 * MiB;
constexpr size_t WS_KSUM = WS_MISC + 3 * MiB;
constexpr size_t WS_SSQ = WS_MISC + 4 * MiB;
constexpr size_t WS_TOK = WS_MISC + 6 * MiB;
constexpr size_t WS_ROPE = WS_MISC + 8 * MiB;
constexpr size_t WS_END = 416 * MiB;

struct TokInfo { int e1, e2; float w1, w2, rstd2; int pad0, pad1, pad2; };

__device__ __forceinline__ float wave_sum(float v) {
#pragma unroll
    for (int o = 1; o < 64; o <<= 1) v += __shfl_xor(v, o);
    return v;
}
__device__ __forceinline__ float wave_max(float v) {
#pragma unroll
    for (int o = 1; o < 64; o <<= 1) v = fmaxf(v, __shfl_xor(v, o));
    return v;
}

struct RopeArgs { double inv_freq[8]; };
__global__ void nk_rope(float2* rope, RopeArgs ra) {
    const int idx = blockIdx.x * blockDim.x + threadIdx.x;
    if (idx >= SEQ * 8) return;
    const int s = idx >> 3, i = idx & 7;
    const double ang = (double)s * ra.inv_freq[i];
    const double TWO_PI = 6.283185307179586476925286766559;
    const double n = rint(ang / TWO_PI);
    const float r = (float)(ang - n * TWO_PI);
    rope[idx] = make_float2(cosf(r), sinf(r));
}

__global__ void __launch_bounds__(256) nk_rowstats(const float* __restrict__ x, const float* __restrict__ g, const float* __restrict__ w_in,
                                                   const float* __restrict__ b_forget, float* rstd1, float* logf) {
    const int row = blockIdx.x, tid = threadIdx.x, lane = tid & 63, wid = tid >> 6;
    __shared__ float red[4][9];
    const float* xr = x + (size_t)row * DM;
    float ss = 0.f, d[8] = {0.f, 0.f, 0.f, 0.f, 0.f, 0.f, 0.f, 0.f};
    for (int k = tid; k < DM; k += 256) {
        const float v = xr[k]; ss += v * v;
        const float vg = v * g[k];
        const float* w = w_in + (size_t)k * INC + 1536;
#pragma unroll
        for (int j = 0; j < 8; ++j) d[j] += vg * w[j];
    }
    ss = wave_sum(ss);
#pragma unroll
    for (int j = 0; j < 8; ++j) d[j] = wave_sum(d[j]);
    if (lane == 0) { red[wid][8] = ss;
#pragma unroll
        for (int j = 0; j < 8; ++j) red[wid][j] = d[j]; }
    __syncthreads();
    if (tid < 8) {
        const float s = red[0][8] + red[1][8] + red[2][8] + red[3][8];
        const float rs = 1.0f / sqrtf(s * (1.0f / DM) + EPS);
        if (tid == 0) rstd1[row] = rs;
        const float z = (red[0][tid] + red[1][tid] + red[2][tid] + red[3][tid]) * rs + b_forget[tid];
        const float lf = fminf(z, 0.f) - log1pf(expf(-fabsf(z)));
        const int b = row / SEQ, s_ = row % SEQ;
        logf[((size_t)b * 8 + tid) * SEQ + s_] = lf;
    }
}

__global__ void nk_cumsum(const float* logf, float* cb) {
    const int i = blockIdx.x * blockDim.x + threadIdx.x;
    if (i >= BATCH * 8) return;
    const float* p = logf + (size_t)i * SEQ; float* o = cb + (size_t)i * SEQ;
    float c = 0.f;
    for (int s = 0; s < SEQ; ++s) { c += p[s]; o[s] = c * LOG2E; }
}

template <class FA, class FB, class FS>
__global__ void __launch_bounds__(256) nk_gemm(int K, FA fa, FB fb, FS fs) {
    __shared__ float As[16][65];
    __shared__ float Bs[16][65];
    const int tid = threadIdx.x, tx = tid & 15, ty = tid >> 4;
    const int m0 = blockIdx.y * 64, n0 = blockIdx.x * 64;
    float acc[4][4];
#pragma unroll
    for (int i = 0; i < 4; ++i)
#pragma unroll
        for (int j = 0; j < 4; ++j) acc[i][j] = 0.f;
    for (int k0 = 0; k0 < K; k0 += 16) {
#pragma unroll
        for (int it = 0; it < 4; ++it) { const int i = tid + it * 256; const int kk = i & 15, mm = i >> 4; As[kk][mm] = fa(m0 + mm, k0 + kk); }
#pragma unroll
        for (int it = 0; it < 4; ++it) { const int i = tid + it * 256; const int nn = i & 63, kk = i >> 6; Bs[kk][nn] = fb(k0 + kk, n0 + nn); }
        __syncthreads();
#pragma unroll
        for (int kk = 0; kk < 16; ++kk) {
            float a[4], b[4];
#pragma unroll
            for (int i = 0; i < 4; ++i) a[i] = As[kk][ty * 4 + i];
#pragma unroll
            for (int j = 0; j < 4; ++j) b[j] = Bs[kk][tx * 4 + j];
#pragma unroll
            for (int i = 0; i < 4; ++i)
#pragma unroll
                for (int j = 0; j < 4; ++j) acc[i][j] += a[i] * b[j];
        }
        __syncthreads();
    }
#pragma unroll
    for (int i = 0; i < 4; ++i)
#pragma unroll
        for (int j = 0; j < 4; ++j) fs(m0 + ty * 4 + i, n0 + tx * 4 + j, acc[i][j]);
}

struct InA { const float* x; const float* g; __device__ float operator()(int m, int k) const { return x[(size_t)m * DM + k] * g[k]; } };
struct InB { const float* w; __device__ float operator()(int k, int n) const { return w[(size_t)k * INC + (n < 1536 ? n : n + 8)]; } };
struct InS { const float* rstd1; half_t* qkv;
    __device__ void operator()(int m, int n, float v) const {
        v *= rstd1[m]; const int blk = n >> 9; if (blk == 0 || blk == 3) v *= C2;
        qkv[(size_t)m * NQKV + n] = (half_t)v; } };

__global__ void nk_rotary(half_t* qkv, const float2* rope) {
    const size_t idx = (size_t)blockIdx.x * blockDim.x + threadIdx.x;
    if (idx >= (size_t)T * 128) return;
    const int i = idx & 7, h = (idx >> 3) & 7, which = (idx >> 6) & 1; const int row = (int)(idx >> 7);
    const int s = row % SEQ;
    half_t* p = qkv + (size_t)row * NQKV + 1536 + which * 512 + h * 64 + i;
    const float t1 = (float)p[0], t2 = (float)p[8];
    const float2 cs = rope[s * 8 + i];
    p[0] = (half_t)(t1 * cs.x - t2 * cs.y);
    p[8] = (half_t)(t2 * cs.x + t1 * cs.y);
}
__global__ void nk_ksum(const half_t* qkv, float* ksum) {
    const int bb = blockIdx.x;
    const int col = threadIdx.x + blockIdx.y * 256;
    const half_t* p = qkv + (size_t)bb * MBLK * NQKV + 2048 + col;
    float s = 0.f;
    for (int r = 0; r < MBLK; ++r) s += (float)p[(size_t)r * NQKV];
    ksum[(size_t)bb * 512 + col] = s;
}

template <bool FOX>
__global__ void __launch_bounds__(256) nk_attn(const half_t* __restrict__ qkv, const float* __restrict__ cb, const float* __restrict__ ksum,
                                               half_t* O, float* ssq) {
    const int lane = threadIdx.x & 63, wid = threadIdx.x >> 6;
    const int gw = blockIdx.x * 4 + wid;
    const int h = gw & 7, tok = gw >> 3;
    const int b = tok / SEQ, t = tok % SEQ;
    const int qoff = FOX ? 0 : 1536, koff = FOX ? 512 : 2048, voff = FOX ? 1024 : 2560;
    float q[64];
    {
        const h8* qp = (const h8*)(qkv + (size_t)tok * NQKV + qoff + h * 64);
#pragma unroll
        for (int c = 0; c < 8; ++c) { const h8 v = qp[c];
#pragma unroll
            for (int j = 0; j < 8; ++j) q[c * 8 + j] = (float)v[j]; }
    }
    unsigned selmask = 0; const int own = t / MBLK;
    float cbt = 0.f; const float* cbp = nullptr;
    if (FOX) { cbp = cb + ((size_t)b * 8 + h) * SEQ; cbt = cbp[t]; }
    else {
        float gate = -INFINITY;
        if (lane < own) { const float* kp = ksum + ((size_t)(b * 16 + lane)) * 512 + h * 64; float s = 0.f;
#pragma unroll
            for (int d = 0; d < 64; ++d) s += q[d] * kp[d];
            gate = s; }
        float gts[16];
#pragma unroll
        for (int n = 0; n < 16; ++n) gts[n] = __shfl(gate, n);
#pragma unroll
        for (int it = 0; it < 3; ++it) {
            float best = -INFINITY; int bi = -1;
#pragma unroll
            for (int n = 0; n < 16; ++n) { const bool ok = (n < own) && !((selmask >> n) & 1u) && (gts[n] > best); if (ok) { best = gts[n]; bi = n; } }
            if (bi >= 0) selmask |= 1u << bi;
        }
        selmask |= 1u << own;
    }
    float m = -INFINITY, l = 0.f; float o[64];
#pragma unroll
    for (int d = 0; d < 64; ++d) o[d] = 0.f;
    const int nchunk = t / 64 + 1;
    for (int c = 0; c < nchunk; ++c) {
        if (!FOX) { if (!((selmask >> (c >> 2)) & 1u)) continue; }
        const int s = c * 64 + lane;
        float sc = -INFINITY;
        if (s <= t) {
            const h8* kp = (const h8*)(qkv + ((size_t)b * SEQ + s) * NQKV + koff + h * 64); float a = 0.f;
#pragma unroll
            for (int cc = 0; cc < 8; ++cc) { const h8 v = kp[cc];
#pragma unroll
                for (int j = 0; j < 8; ++j) a += q[cc * 8 + j] * (float)v[j]; }
            sc = a; if (FOX) sc += cbt - cbp[s];
        }
        const float cm = wave_max(sc);
        const float mn = fmaxf(m, cm);
        const float f = exp2f(m - mn);
        const float p = exp2f(sc - mn);
        l = l * f + p;
        m = mn;
        if (s <= t) {
            const h8* vp = (const h8*)(qkv + ((size_t)b * SEQ + s) * NQKV + voff + h * 64);
#pragma unroll
            for (int cc = 0; cc < 8; ++cc) { const h8 v = vp[cc];
#pragma unroll
                for (int j = 0; j < 8; ++j) o[cc * 8 + j] = o[cc * 8 + j] * f + p * (float)v[j]; }
        } else {
#pragma unroll
            for (int d = 0; d < 64; ++d) o[d] *= f;
        }
    }
    l = wave_sum(l);
    const float il = 1.0f / l;
    float mine = 0.f;
#pragma unroll
    for (int d = 0; d < 64; ++d) { const float v = wave_sum(o[d]); if (lane == d) mine = v; }
    const half_t hv = (half_t)(mine * il);
    O[(size_t)tok * DM + (FOX ? 0 : 512) + h * 64 + lane] = hv;
    const float fv = (float)hv; const float sq = wave_sum(fv * fv);
    if (lane == 0) ssq[(size_t)tok * 16 + (FOX ? 0 : 8) + h] = sq;
}

struct OutA { const half_t* O; const float* ssq; const float* gf; const float* gm;
    __device__ float operator()(int m, int k) const {
        const float* sp = ssq + (size_t)m * 16 + (k < 512 ? 0 : 8);
        float s = 0.f;
#pragma unroll
        for (int j = 0; j < 8; ++j) s += sp[j];
        const float rs = 1.0f / sqrtf(s * (1.0f / 512.0f) + EPS);
        return (float)O[(size_t)m * DM + k] * rs * (k < 512 ? gf[k] : gm[k - 512]); } };
struct OutB { const float* w; __device__ float operator()(int k, int n) const { return w[(size_t)k * DM + n]; } };
struct OutS { const float* x; float* x2; __device__ void operator()(int m, int n, float v) const { x2[(size_t)m * DM + n] = x[(size_t)m * DM + n] + v; } };

__global__ void __launch_bounds__(256) nk_router(const float* __restrict__ x2, const float* __restrict__ g, const float* __restrict__ wrg, const float* __restrict__ brg,
                                                 const float* __restrict__ wre, const float* __restrict__ bre, TokInfo* tok) {
    const int row = blockIdx.x, tid = threadIdx.x, lane = tid & 63, wid = tid >> 6;
    __shared__ float hs[DM]; __shared__ float red[4]; __shared__ float lg[36];
    const float* xr = x2 + (size_t)row * DM;
    float ss = 0.f;
    for (int k = tid; k < DM; k += 256) { const float v = xr[k]; ss += v * v; hs[k] = v * g[k]; }
    ss = wave_sum(ss); if (lane == 0) red[wid] = ss;
    __syncthreads();
    const float rs = 1.0f / sqrtf((red[0] + red[1] + red[2] + red[3]) * (1.0f / DM) + EPS);
    if (tid < 36) {
        float s = 0.f;
        if (tid < 4) { for (int k = 0; k < DM; ++k) s += hs[k] * wrg[(size_t)k * 4 + tid]; s = s * rs + brg[tid]; }
        else { const int j = tid - 4; for (int k = 0; k < DM; ++k) s += hs[k] * wre[(size_t)k * 32 + j]; s = s * rs + bre[j]; }
        lg[tid] = s;
    }
    __syncthreads();
    if (tid == 0) {
        int gi = 0; float gm = lg[0];
        for (int j = 1; j < 4; ++j) if (lg[j] > gm) { gm = lg[j]; gi = j; }
        float gs = 0.f; for (int j = 0; j < 4; ++j) gs += expf(lg[j] - gm);
        const float gtop = 1.0f / gs;
        const float* el = lg + 4 + gi * 8;
        int i1 = 0; float m1 = el[0];
        for (int j = 1; j < 8; ++j) if (el[j] > m1) { m1 = el[j]; i1 = j; }
        int i2 = -1; float m2 = -INFINITY;
        for (int j = 0; j < 8; ++j) if (j != i1 && el[j] > m2) { m2 = el[j]; i2 = j; }
        const float e2 = expf(m2 - m1);
        const float w1 = gtop / (1.0f + e2), w2 = gtop * e2 / (1.0f + e2);
        TokInfo ti; ti.e1 = gi * 8 + i1; ti.e2 = gi * 8 + i2; ti.w1 = w1; ti.w2 = w2; ti.rstd2 = rs; ti.pad0 = ti.pad1 = ti.pad2 = 0;
        tok[row] = ti;
    }
}

__global__ void __launch_bounds__(256) nk_moe(const float* __restrict__ x2, const float* __restrict__ g, const TokInfo* __restrict__ tok,
                                              const float* __restrict__ wg, const float* __restrict__ wu, const float* __restrict__ wd,
                                              const float* __restrict__ gfin, float* out) {
    const int row = blockIdx.x, tid = threadIdx.x, lane = tid & 63, wid = tid >> 6;
    __shared__ float hs[DM]; __shared__ float act[DEXP]; __shared__ float red[4];
    const TokInfo ti = tok[row];
    const float* xr = x2 + (size_t)row * DM;
    float xv[4];
#pragma unroll
    for (int j = 0; j < 4; ++j) { const int k = tid + 256 * j; xv[j] = xr[k]; hs[k] = xv[j] * ti.rstd2 * g[k]; }
    __syncthreads();
    float y[4] = {0.f, 0.f, 0.f, 0.f};
    for (int sl = 0; sl < 2; ++sl) {
        const int e = sl == 0 ? ti.e1 : ti.e2; const float cw = sl == 0 ? ti.w1 : ti.w2;
        const float* pg = wg + (size_t)e * DM * DEXP + tid; const float* pu = wu + (size_t)e * DM * DEXP + tid;
        float a = 0.f, u = 0.f;
        for (int k = 0; k < DM; ++k) { const float hv = hs[k]; a += hv * pg[(size_t)k * DEXP]; u += hv * pu[(size_t)k * DEXP]; }
        const float sv = a / (1.0f + expf(-a));
        __syncthreads();
        act[tid] = sv * u * cw;
        __syncthreads();
        const float* pd = wd + (size_t)e * DEXP * DM;
        for (int f = 0; f < DEXP; ++f) { const float av = act[f];
#pragma unroll
            for (int j = 0; j < 4; ++j) y[j] += av * pd[(size_t)f * DM + tid + 256 * j]; }
    }
    float ss = 0.f;
#pragma unroll
    for (int j = 0; j < 4; ++j) { y[j] += xv[j]; ss += y[j] * y[j]; }
    ss = wave_sum(ss); if (lane == 0) red[wid] = ss;
    __syncthreads();
    const float rs = 1.0f / sqrtf((red[0] + red[1] + red[2] + red[3]) * (1.0f / DM) + EPS);
#pragma unroll
    for (int j = 0; j < 4; ++j) { const int k = tid + 256 * j; out[(size_t)row * DM + k] = y[j] * rs * gfin[k]; }
}


#define LAS __attribute__((address_space(3)))
#define GAS __attribute__((address_space(1)))
typedef unsigned u32x4 __attribute__((ext_vector_type(4)));
typedef unsigned u32x2 __attribute__((ext_vector_type(2)));
typedef float f32x2 __attribute__((ext_vector_type(2)));
typedef _Float16 h2v __attribute__((ext_vector_type(2)));
typedef float f32x16 __attribute__((ext_vector_type(16)));
typedef short s16x4 __attribute__((ext_vector_type(4)));
typedef int i32x4 __attribute__((ext_vector_type(4)));
typedef int i32x8 __attribute__((ext_vector_type(8)));

__device__ __forceinline__ unsigned pkh(float lo, float hi) { f32x2 v = {lo, hi}; h2v h = __builtin_convertvector(v, h2v); return __builtin_bit_cast(unsigned, h); }

constexpr size_t WS_W1T = 2 * MiB;
constexpr size_t WS_WOT = 8 * MiB;
constexpr size_t WS_WRT = 10 * MiB;
constexpr size_t WS_WGU = 11 * MiB;
constexpr size_t WS_WD = 43 * MiB;
constexpr size_t WS_H8 = 456 * MiB;
constexpr size_t WS_XH = 256 * MiB;
#ifndef MOBA_SPARSE
#define MOBA_SPARSE 0
#endif
constexpr size_t WS_ACT = MOBA_SPARSE ? 64 * MiB : 416 * MiB;
constexpr size_t WS_Y = 104 * MiB;
constexpr size_t WS_CNT = WS_MISC + 9 * MiB;
constexpr size_t WS_NRM = WS_MISC + 10 * MiB;
constexpr size_t WS_CNTQ = WS_MISC + 11 * MiB;
constexpr size_t WS_LQ = WS_XH;
constexpr size_t WS_PML = WS_XH + 16 * MiB;
constexpr size_t WS_PO = 416 * MiB;
constexpr size_t WS_END2 = 512 * MiB;
constexpr size_t WS_TRDY = WS_MISC + 12 * MiB;
constexpr size_t WS_PRDY = WS_MISC + 13 * MiB;
constexpr size_t WS_LTOK = WS_MISC + 16 * MiB;
constexpr size_t WS_LRS = WS_MISC + 20 * MiB;
constexpr size_t WS_LCW = WS_MISC + 24 * MiB;
constexpr size_t WS_WV8 = WS_MISC + 28 * MiB;
constexpr size_t WS_X8 = 456 * MiB;

constexpr int RING_BYTES = 131072;
constexpr int LDSX_OFF = RING_BYTES;
constexpr int LX_HIST = 64, LX_EBASE = 192, LX_TOFF = 512, LX_RTOK = 1024, LX_RRS = 1024 + 3072, LX_RCW = 1024 + 6144, LX_TEXP = 10240;
constexpr int LDS_BYTES = 147456;
constexpr int MAXU = 3;

namespace pg8 {
constexpr int BM = 256, BK = 64, HALF = 128, HTB = HALF * BK * 2, STAGE_BYTES = 8 * HTB;
__host__ __device__ __forceinline__ int lds_byte(int r, int c) { const int st = (r >> 4) * 2 + (c >> 5), rr = r & 15, cc = c & 31, ob = rr * 64 + cc * 2; return st * 1024 + (ob ^ (((ob >> 9) & 1) << 5)); }
__host__ __device__ __forceinline__ void stage_rc(int b, int& R, int& C) { const int st = b / 1024, sb = b % 1024, swz = sb ^ (((sb >> 9) & 1) << 5); R = (st >> 1) * 16 + swz / 64; C = (st & 1) * 32 + (swz % 64) / 2; }
__host__ __device__ __forceinline__ int perm32(int rho) { const int n = rho >> 4, i = rho & 15; return 8 * (i >> 2) + 4 * n + (i & 3); }
__host__ __device__ __forceinline__ int perm256(int p) { return 64 * ((p >> 5) & 3) + 16 * ((p >> 2) & 3) + 4 * ((p >> 4) & 1) + (p & 3); }

struct GUnit { const char* A; const char* B; int pm, pn, aux, par; };

template <class Epi, class Sched, bool ALIGN_EPI, bool F8 = false>
__device__ __forceinline__ void gemm_phase(LAS unsigned char* lds, const int K, const Sched& S, const Epi& E) {
    const int tid = threadIdx.x, wid = __builtin_amdgcn_readfirstlane(tid >> 6), lane = tid & 63, wr = wid >> 2, wc = wid & 3, fr = lane & 15, fq = lane >> 4;
    const int nt = K / BK;
    int Rr[2], Cc[2]; unsigned voffB[2];
#pragma unroll
    for (int i = 0; i < 2; ++i) { stage_rc(tid * 16 + i * 8192, Rr[i], Cc[i]); const int Rb = ((int)Epi::PERM == 2) ? perm256(Rr[i]) : Epi::PERM ? ((Rr[i] & ~31) + perm32(Rr[i] & 31)) : Rr[i]; voffB[i] = (unsigned)(Rb * K + Cc[i]) * 2u; }
    const size_t kstep = (size_t)(BK * 2);
    const size_t hstep = (size_t)(((int)Epi::PERM == 2) ? 8 : HALF) * K * 2;
    const unsigned ldsw = (unsigned)wid * 1024u;
    const int aoff = lds_byte(wr * 64 + fr, fq * 8), boff = lds_byte(wc * 32 + fr, fq * 8);
#define PG8_SA(b, h) (((b) * 2 + (h)) * HTB)
#define PG8_SB(b, h) ((4 + (b) * 2 + (h)) * HTB)
#define PG8_STAGE(bufoff, gbase, voff) do { _Pragma("unroll") for (int _i = 0; _i < 2; ++_i) \
        __builtin_amdgcn_global_load_lds((const unsigned*)((const char*)(gbase) + (voff)[_i]), (LAS unsigned*)(lds + (bufoff) + ldsw + _i * 8192), 16, 0, 0); } while (0)
#define PG8_LDA(dst, b, h) do { _Pragma("unroll") for (int m = 0; m < 4; ++m) _Pragma("unroll") for (int k = 0; k < 2; ++k) dst[m][k] = *(const LAS h8*)(lds + PG8_SA(b, h) + aoff + m * 2048 + k * 1024); } while (0)
#define PG8_LDB(dst, b, h) do { _Pragma("unroll") for (int n = 0; n < 2; ++n) _Pragma("unroll") for (int k = 0; k < 2; ++k) dst[n][k] = *(const LAS h8*)(lds + PG8_SB(b, h) + boff + n * 2048 + k * 1024); } while (0)
#define PG8_MMA(ai, bj, At, Bt) do { __builtin_amdgcn_s_setprio(1); _Pragma("unroll") for (int m = 0; m < 4; ++m) _Pragma("unroll") for (int n = 0; n < 2; ++n) { \
        if constexpr (F8) { const i32x8 b8_ = __builtin_shufflevector(__builtin_bit_cast(i32x4, Bt[n][0]), __builtin_bit_cast(i32x4, Bt[n][1]), 0, 1, 2, 3, 4, 5, 6, 7), \
                                        a8_ = __builtin_shufflevector(__builtin_bit_cast(i32x4, At[m][0]), __builtin_bit_cast(i32x4, At[m][1]), 0, 1, 2, 3, 4, 5, 6, 7); \
            asm volatile("v_mfma_scale_f32_16x16x128_f8f6f4 %0, %1, %2, %0, %3, %3 op_sel_hi:[0,0,0]" : "+v"(acc[ai][bj][m][n]) : "v"(b8_), "v"(a8_), "v"(sc127)); } \
        else { _Pragma("unroll") for (int k = 0; k < 2; ++k) acc[ai][bj][m][n] = __builtin_amdgcn_mfma_f32_16x16x32_f16(Bt[n][k], At[m][k], acc[ai][bj][m][n], 0, 0, 0); } } __builtin_amdgcn_s_setprio(0); } while (0)
#define PG8_WAIT_V(n) asm volatile("s_waitcnt vmcnt(" #n ")" ::: "memory")
#define PG8_WAIT_L(n) asm volatile("s_waitcnt lgkmcnt(" #n ")" ::: "memory")
#define PG8_BAR __builtin_amdgcn_s_barrier()
#define PG8_SCHED __builtin_amdgcn_sched_barrier(0)
#define PG8_OFFS(u, o) do { _Pragma("unroll") for (int _h = 0; _h < 2; ++_h) _Pragma("unroll") for (int _i = 0; _i < 2; ++_i) o[_h][_i] = S.aoff(u, _h * HALF + Rr[_i], Cc[_i], K); } while (0)
    GUnit cur, nxt; int ui = 0;
    if (!S.next(0, cur)) return;
    int sc127 = 127; asm volatile("" : "+v"(sc127));
    (void)sc127;
    f32x4 acc[2][2][4][2];
#pragma unroll
    for (int a = 0; a < 2; ++a)
#pragma unroll
        for (int b = 0; b < 2; ++b)
#pragma unroll
            for (int m = 0; m < 4; ++m)
#pragma unroll
                for (int n = 0; n < 2; ++n) acc[a][b][m][n] = (f32x4){0.f, 0.f, 0.f, 0.f};
    h8 At[4][2], B0[2][2], B1[2][2];
    unsigned oc[2][2], on[2][2];
    PG8_OFFS(cur, oc);
    const char* cA = cur.A; const char* cB = cur.B;
    PG8_STAGE(PG8_SB(0, 0), cB, voffB); PG8_STAGE(PG8_SB(0, 1), cB + hstep, voffB); PG8_STAGE(PG8_SA(0, 0), cA, oc[0]); PG8_STAGE(PG8_SA(0, 1), cA, oc[1]);
    if (wr == 1) PG8_BAR;
    PG8_WAIT_V(2); PG8_BAR;
    PG8_STAGE(PG8_SB(1, 0), cB + kstep, voffB); PG8_STAGE(PG8_SA(1, 0), cA + kstep, oc[0]); PG8_STAGE(PG8_SB(1, 1), cB + hstep + kstep, voffB);
    PG8_WAIT_V(6); PG8_BAR;
    for (;;) {
        bool has_next = false; const char* nA = cA; const char* nB = cB;
        if constexpr (Sched::DEFER) { S.prefetch(ui + 1);
#pragma unroll
            for (int h = 0; h < 2; ++h)
#pragma unroll
                for (int i = 0; i < 2; ++i) on[h][i] = oc[h][i]; }
        else { has_next = S.next(ui + 1, nxt); nA = has_next ? nxt.A : cA; nB = has_next ? nxt.B : cB;
            if constexpr (Sched::GATHER) { if (has_next) { PG8_OFFS(nxt, on); } else {
#pragma unroll
                for (int h = 0; h < 2; ++h)
#pragma unroll
                    for (int i = 0; i < 2; ++i) on[h][i] = oc[h][i]; } } }
        cur.par = ui & 1;
        if constexpr (Epi::HAS_MID) E.unit_begin(cur);
#pragma unroll 1
        for (int t = 0; t < nt; t += 2) {
            const bool last = (t == nt - 2);
            if constexpr (Sched::DEFER) { if (last) { has_next = S.next(ui + 1, nxt); nA = has_next ? nxt.A : cA; nB = has_next ? nxt.B : cB; } }
            if constexpr (Epi::HAS_MID) { if (t == (nt >> 1)) E.mid(acc, cur, wr, fr); }
            const char* a1 = cA + (size_t)(t + 1) * kstep;
            const char* a2 = last ? nA : cA + (size_t)(t + 2) * kstep; const char* b2 = last ? nB : cB + (size_t)(t + 2) * kstep;
            const char* a3 = a2 + kstep; const char* b3 = b2 + kstep;
            unsigned o2[2][2];
#pragma unroll
            for (int h = 0; h < 2; ++h)
#pragma unroll
                for (int i = 0; i < 2; ++i) { if constexpr (Sched::GATHER) o2[h][i] = last ? on[h][i] : oc[h][i]; else o2[h][i] = oc[h][i]; }
            PG8_LDB(B0, 0, 0); PG8_LDB(B1, 0, 1); PG8_SCHED; PG8_LDA(At, 0, 0); PG8_STAGE(PG8_SA(1, 1), a1, oc[1]);
            PG8_WAIT_V(8); PG8_WAIT_L(0); PG8_BAR; PG8_MMA(0, 0, At, B0); PG8_MMA(0, 1, At, B1); PG8_BAR; PG8_SCHED;
            PG8_LDA(At, 0, 1); PG8_STAGE(PG8_SB(0, 0), b2, voffB); PG8_STAGE(PG8_SB(0, 1), b2 + hstep, voffB); PG8_STAGE(PG8_SA(0, 0), a2, o2[0]);
            PG8_WAIT_V(8); PG8_WAIT_L(0); PG8_BAR; PG8_MMA(1, 0, At, B0); PG8_MMA(1, 1, At, B1); PG8_BAR; PG8_SCHED;
            PG8_LDB(B0, 1, 0); PG8_LDB(B1, 1, 1); PG8_SCHED; PG8_LDA(At, 1, 0); PG8_STAGE(PG8_SA(0, 1), a2, o2[1]);
            PG8_WAIT_V(8); PG8_WAIT_L(0); PG8_BAR; PG8_MMA(0, 0, At, B0); PG8_MMA(0, 1, At, B1); PG8_BAR; PG8_SCHED;
            PG8_LDA(At, 1, 1); PG8_STAGE(PG8_SB(1, 0), b3, voffB); PG8_STAGE(PG8_SB(1, 1), b3 + hstep, voffB); PG8_STAGE(PG8_SA(1, 0), a3, o2[0]);
            PG8_WAIT_V(8); PG8_WAIT_L(0); PG8_BAR; PG8_MMA(1, 0, At, B0); PG8_MMA(1, 1, At, B1); PG8_BAR; PG8_SCHED;
        }
        if constexpr (F8) asm volatile("s_nop 15\n\ts_nop 15" ::: "memory");
        if constexpr (ALIGN_EPI) { if (wr == 0) PG8_BAR; }
        E(acc, cur, wr, wc, fr, fq);
        if (!has_next) break;
#pragma unroll
        for (int a = 0; a < 2; ++a)
#pragma unroll
            for (int b = 0; b < 2; ++b)
#pragma unroll
                for (int m = 0; m < 4; ++m)
#pragma unroll
                    for (int n = 0; n < 2; ++n) acc[a][b][m][n] = (f32x4){0.f, 0.f, 0.f, 0.f};
        cur = nxt; cA = nA; cB = nB; ++ui;
        if constexpr (Sched::GATHER) {
#pragma unroll
        for (int h = 0; h < 2; ++h)
#pragma unroll
            for (int i = 0; i < 2; ++i) oc[h][i] = on[h][i]; }
        if constexpr (ALIGN_EPI) { if (wr == 1) PG8_BAR; }
    }
    PG8_WAIT_V(0);
    if constexpr (!ALIGN_EPI) { if (wr == 0) PG8_BAR; }
    PG8_BAR;
#undef PG8_SA
#undef PG8_SB
#undef PG8_STAGE
#undef PG8_LDA
#undef PG8_LDB
#undef PG8_MMA
#undef PG8_WAIT_V
#undef PG8_WAIT_L
#undef PG8_BAR
#undef PG8_SCHED
#undef PG8_OFFS
}

struct DenseOrder {
    static constexpr int NXCD = 8, WGM = 4; static constexpr bool GATHER = false, DEFER = false;
    const char* A; const char* Bt; int K, nM, nN, nwg, G, c;
    __device__ void init(const void* A_, const void* Bt_, int M, int N, int K_, int G_, int c_) { A = (const char*)A_; Bt = (const char*)Bt_; K = K_; nM = M / BM; nN = N / BM; nwg = nM * nN; G = G_; c = c_; }
    __device__ __forceinline__ bool next(int i, GUnit& u) const {
        const long L = (long)i * G + c; if (L >= nwg) return false;
        int wgid = (int)L; { const int q = nwg / NXCD, r = nwg % NXCD, xcd = wgid % NXCD, off = wgid / NXCD; wgid = (xcd < r ? xcd * (q + 1) : r * (q + 1) + (xcd - r) * q) + off; }
        const int nig = WGM * nN, gid = wgid / nig, fm = gid * WGM, gsz = (nM - fm) < WGM ? (nM - fm) : WGM;
        u.pm = fm + ((wgid % nig) % gsz); u.pn = (wgid % nig) / gsz; u.aux = 0;
        u.A = A + (size_t)u.pm * BM * K * 2; u.B = Bt + (size_t)u.pn * BM * K * 2; return true;
    }
    __device__ __forceinline__ unsigned aoff(const GUnit&, int row, int C, int K_) const { return (unsigned)(row * K_ + C) * 2u; }
};
struct QkvOrder {
    static constexpr bool GATHER = false, DEFER = false;
    DenseOrder d; int mode; const char* Bbase;
    __device__ __forceinline__ bool next(int i, GUnit& u) const {
        if (!d.next(i, u)) return false;
        const int pc = u.pn;
        if (mode == 0) { u.pn = pc + ((pc >> 2) << 1); u.B = Bbase + (size_t)u.pn * BM * d.K * 2; }
        else { u.pn = 4 + pc + ((pc >> 1) << 2); u.B = Bbase + (size_t)pc * BM * d.K * 2; }
        return true; }
    __device__ __forceinline__ unsigned aoff(const GUnit&, int row, int C, int K_) const { return (unsigned)(row * K_ + C) * 2u; }
};
}

namespace att {
constexpr int NW = 8, QBLK = 32, QB = QBLK * NW, KVBLK = 64;
constexpr int QP = NQKV, OP = DM, KP = HD;
__device__ __forceinline__ int crow(int r, int hi) { return (r & 3) + 8 * (r >> 2) + 4 * hi; }
#define SBAR() __builtin_amdgcn_sched_barrier(0)
__device__ __forceinline__ void cmask(f32x16& p0, f32x16& p1, int jb, int qrel, int hi) {
    const float NEG = -INFINITY; const int kb = 64 * jb + 4 * hi;
#pragma unroll
    for (int r = 0; r < 16; ++r) { const int kv = kb + (r & 3) + 8 * (r >> 2); if (kv > qrel) p0[r] = NEG; if (kv + 32 > qrel) p1[r] = NEG; }
}
constexpr int NSLOT = 3, SLOTB = 8192;
constexpr int LDS_K = 0, LDS_V = NSLOT * SLOTB, LDS_WS = 2 * NSLOT * SLOTB, LDS_OST = LDS_WS + NW * 64 * 4, LDS_CB = LDS_OST + NW * 4096, LDS_END = LDS_CB + SEQ * 4;
constexpr int LDS_CBH = 102400, LDS_KSH = LDS_CBH + SEQ * 4, LDS_HT_END = LDS_KSH + 15 * HD * 4;
constexpr float FLOOR2 = -1000.0f;
__device__ __forceinline__ void glds16(const void* gsrc, unsigned lds_dst) { unsigned keep;
    asm volatile("s_mov_b32 %0, m0\n\ts_mov_b32 m0, %2\n\ts_nop 0\n\tglobal_load_lds_dwordx4 %1, off\n\ts_mov_b32 m0, %0" : "=&s"(keep) : "v"(gsrc), "s"(lds_dst) : "memory"); }
__device__ __forceinline__ float max3f(float a, float b, float c) { float r; asm("v_max3_f32 %0, %1, %2, %3" : "=v"(r) : "v"(a), "v"(b), "v"(c)); return r; }
__device__ __forceinline__ float max2f(float a, float b) { float r; asm("v_max_f32_e32 %0, %1, %2" : "=v"(r) : "v"(a), "v"(b)); return r; }
__device__ __forceinline__ float fsub_s(float a, float b) { float r; asm("v_sub_f32_e32 %0, %1, %2" : "=v"(r) : "v"(a), "v"(b)); return r; }
#define WAIT_BAR(N) asm volatile("s_waitcnt vmcnt(" #N ") lgkmcnt(0)\n\ts_barrier" ::: "memory")
typedef LAS const char* lds_cptr;
typedef short v4i16_t __attribute__((ext_vector_type(4)));
__device__ __forceinline__ void kload8(h8* kf, lds_cptr kp) {
    kf[0] = *(const LAS h8*)(kp);        kf[1] = *(const LAS h8*)(kp + 512);
    kf[2] = *(const LAS h8*)(kp + 2048); kf[3] = *(const LAS h8*)(kp + 2560);
    kf[4] = *(const LAS h8*)(kp + 4096); kf[5] = *(const LAS h8*)(kp + 4608);
    kf[6] = *(const LAS h8*)(kp + 6144); kf[7] = *(const LAS h8*)(kp + 6656);
}
__device__ __forceinline__ void kload2(h8* kf, lds_cptr kp, int j) { kf[2 * j] = *(const LAS h8*)(kp + j * 2048); kf[2 * j + 1] = *(const LAS h8*)(kp + j * 2048 + 512); }
__device__ __forceinline__ s16x4 vtr(lds_cptr p) { return __builtin_bit_cast(s16x4, __builtin_amdgcn_ds_read_tr16_b64_v4i16((LAS v4i16_t*)p)); }
__device__ __forceinline__ float rowmax(const f32x16& p0, const f32x16& p1) {
    float a = max3f(p0[0], p0[1], p1[0]), b = max3f(p0[2], p0[3], p1[1]); a = max3f(a, p1[2], p1[3]);
#pragma unroll
    for (int r = 4; r < 16; r += 4) { a = max3f(a, p0[r], p0[r + 1]); b = max3f(b, p0[r + 2], p0[r + 3]); a = max3f(a, p1[r], p1[r + 1]); b = max3f(b, p1[r + 2], p1[r + 3]); }
    const float m = max2f(a, b);
    auto rr = __builtin_amdgcn_permlane32_swap(__float_as_uint(m), __float_as_uint(m), false, false);
    return max2f(__uint_as_float(rr[0]), __uint_as_float(rr[1]));
}
#define MF16(a, b, c) __builtin_amdgcn_mfma_f32_32x32x16_f16(a, b, c, 0, 0, 0)
__device__ __forceinline__ void pv(f32x16* o, int vb, h8 pa0, h8 pa1, h8 pa2, h8 pa3) {
#pragma unroll
    for (int d0 = 0; d0 < 2; ++d0) { s16x4 lo[4], hi[4];
#pragma unroll
        for (int ks = 0; ks < 4; ++ks) {
            asm volatile("ds_read_b64_tr_b16 %0,%1 offset:%c2" : "=&v"(lo[ks]) : "v"(vb), "i"(d0 * 4096 + ks * 1024) : "memory");
            asm volatile("ds_read_b64_tr_b16 %0,%1 offset:%c2" : "=&v"(hi[ks]) : "v"(vb), "i"(d0 * 4096 + ks * 1024 + 512) : "memory"); }
        asm volatile("s_waitcnt lgkmcnt(0)" ::: "memory"); SBAR();
#define PK(k) __builtin_bit_cast(h8, (__attribute__((ext_vector_type(8))) short){lo[k][0], lo[k][1], lo[k][2], lo[k][3], hi[k][0], hi[k][1], hi[k][2], hi[k][3]})
        o[d0] = MF16(pa0, PK(0), o[d0]);
        o[d0] = MF16(pa1, PK(1), o[d0]);
        o[d0] = MF16(pa2, PK(2), o[d0]);
        o[d0] = MF16(pa3, PK(3), o[d0]);
#undef PK
    }
}

__device__ __forceinline__ void publish(int* prdy, int& pub) {
    if (pub >= 0) { asm volatile("s_waitcnt vmcnt(0)" ::: "memory"); if ((threadIdx.x & 63) == 0) __hip_atomic_fetch_add(prdy + pub, 1, __ATOMIC_RELAXED, __HIP_MEMORY_SCOPE_AGENT); pub = -1; }
}
__device__ __forceinline__ void head_tables(int b, int h, const float* ksum, char* shm, int tid) {
    const lds_cptr shm3 = (lds_cptr)shm; LAS float* ksh = (LAS float*)(shm3 + LDS_KSH);
    for (int i = tid; i < 15 * HD; i += NW * 64) ksh[i] = ksum[((size_t)(b * NBLK + (i >> 6))) * 512 + h * HD + (i & 63)];
    asm volatile("s_waitcnt vmcnt(0) lgkmcnt(0)\n\ts_barrier" ::: "memory");
}

struct AttNext { const half_t* K; const half_t* V; int b, h, qb, valid; };
template <bool FOX, int THRL, bool MERGE = false>
__device__ __forceinline__ int attn_unit(int b, int h, int qb, int NTU, const half_t* Q, const half_t* __restrict__ K, const half_t* __restrict__ V, half_t* O,
                                          const float* __restrict__ cbg, const float* __restrict__ ksum, const float* __restrict__ nrm, float* ssq, char* shm,
                                          int s0, bool pre, const AttNext nx, int* prdy, int& pub, const half_t* parto = nullptr, const float* partml = nullptr) {
    int tid_ = threadIdx.x; asm volatile("" : "+v"(tid_));
    const int tid = tid_, lane = tid & 63, r32 = lane & 31, hi = lane >> 5; const int wid = __builtin_amdgcn_readfirstlane(tid >> 6);
    const long rowbase = (long)b * SEQ; const int q0 = qb * QB;
    const size_t hbase = ((size_t)b * NH + h) * SEQ * KP;
    const half_t* Qw = Q + hbase + (size_t)(q0 + wid * QBLK) * KP;
    const half_t* Kh = K + hbase; const half_t* Vh = V + hbase;
    const unsigned lds0 = (unsigned)(uintptr_t)shm;
    float* wsf = (float*)(shm + LDS_WS) + wid * 64;
    const int NT = (q0 + QB) / KVBLK;
    const half_t* ksrc = Kh + ((long)(NT - 1) * KVBLK + lane) * KP + wid * 8;
    const half_t* vsrc = Vh + ((long)(NT - 1) * KVBLK + 16 * (wid & 3) + (lane >> 2)) * KP + (wid >> 2) * 32 + (lane & 3) * 8;
    const unsigned kdst = lds0 + LDS_K + wid * 1024, vdst = lds0 + LDS_V + wid * 1024;
#define DMA_K(t, slot) glds16(ksrc - (long)(t) * KVBLK * KP, (unsigned)__builtin_amdgcn_readfirstlane(kdst + (slot)))
#define DMA_V(t, slot) glds16(vsrc - (long)(t) * KVBLK * KP, (unsigned)__builtin_amdgcn_readfirstlane(vdst + (slot)))
    const int vb0 = (int)(lds0 + LDS_V) + ((lane >> 4) & 1) * 32 + (lane & 3) * 8 + (4 * hi + ((lane & 15) >> 2)) * 64;
    const char* Kbase = shm + LDS_K; h8 kf[8];
    const lds_cptr shm3 = (lds_cptr)shm; const lds_cptr kp0 = shm3 + LDS_K + hi * 1024 + r32 * 16; const lds_cptr vp0 = shm3 + LDS_V + ((lane >> 4) & 1) * 32 + (lane & 3) * 8 + (4 * hi + ((lane & 15) >> 2)) * 64;
    const LAS float* cbl = (const LAS float*)(shm3 + LDS_CB);
    float cref = 0.f;
    const int s1 = (s0 == (NSLOT - 1) * SLOTB) ? 0 : s0 + SLOTB, s2 = (s1 == (NSLOT - 1) * SLOTB) ? 0 : s1 + SLOTB;
    if (!pre) { DMA_K(0, s0); DMA_V(0, s0); DMA_K(1, s1); }
    h8 qr[4];
#pragma unroll
    for (int d0 = 0; d0 < 4; ++d0) qr[d0] = *reinterpret_cast<const h8*>(&Qw[(long)r32 * KP + d0 * 16 + hi * 8]);
    unsigned selmask = 0xffffffffu;
    if constexpr (FOX) {
        const float* cbp = cbg + ((size_t)b * NH + h) * SEQ;
        cref = cbp[q0 + QB - 1];
        for (int i = tid * 4; i < q0 + QB; i += NW * 64 * 4) *(LAS f32x4*)(shm3 + LDS_CB + (size_t)i * 4) = *(const f32x4*)(cbp + i);
        const half_t* Kw = Kh + ((long)q0 + wid * QBLK + r32) * KP + hi * 8;
        float qq = 0.f, qk = 0.f;
#pragma unroll
        for (int d0 = 0; d0 < 4; ++d0) { const h8 kv = *reinterpret_cast<const h8*>(Kw + d0 * 16);
#pragma unroll
            for (int j = 0; j < 8; ++j) { const float qf = (float)qr[d0][j]; qq += qf * qf; qk += qf * (float)kv[j]; } }
        qq += __shfl_xor(qq, 32); qk += __shfl_xor(qk, 32);
        const float* nr = nrm + ((size_t)b * NH + h) * 4;
        float need = 36.01f + sqrtf(qq) * sqrtf(nr[2] + nr[3]) * 1.001f - qk + cbp[q0 + wid * QBLK + r32];
#pragma unroll
        for (int o = 1; o < 32; o <<= 1) need = __builtin_fmaxf(need, __shfl_xor(need, o));
        if (lane == 0) wsf[63] = need;
    } else {
      if constexpr (MERGE) { selmask = 1u << qb; } else {
        float v0 = -INFINITY, v1 = -INFINITY, v2 = -INFINITY; int i0 = 31, i1 = 31, i2 = 31;
#pragma unroll 1
        for (int n = 0; n < qb; ++n) {
            const LAS float* kp = (const LAS float*)(shm3 + LDS_KSH) + n * HD + hi * 8; float s = 0.f;
#pragma unroll
            for (int d0 = 0; d0 < 4; ++d0) { const f32x4 k0 = *(const LAS f32x4*)(kp + d0 * 16), k1 = *(const LAS f32x4*)(kp + d0 * 16 + 4);
                s += (float)qr[d0][0] * k0[0] + (float)qr[d0][1] * k0[1] + (float)qr[d0][2] * k0[2] + (float)qr[d0][3] * k0[3] + (float)qr[d0][4] * k1[0] + (float)qr[d0][5] * k1[1] + (float)qr[d0][6] * k1[2] + (float)qr[d0][7] * k1[3]; }
            s += __shfl_xor(s, 32);
            const bool g0 = s > v0, g1 = s > v1, g2 = s > v2;
            v2 = g1 ? v1 : (g2 ? s : v2); i2 = g1 ? i1 : (g2 ? n : i2);
            v1 = g0 ? v0 : (g1 ? s : v1); i1 = g0 ? i0 : (g1 ? n : i1);
            v0 = g0 ? s : v0; i0 = g0 ? n : i0;
        }
        selmask = ((1u << i0) | (1u << i1) | (1u << i2) | (1u << qb)) & 0xffffu;
      }
    }
    float mhat = 0.f, l_reg = 0.f; f32x16 o[2]; o[0] = f32x16{}; o[1] = f32x16{};
    const int qrel = wid * QBLK + r32;
    bool resc = false;
#define RESC() do { if (resc) { asm volatile("s_waitcnt lgkmcnt(0)" ::: "memory"); \
        _Pragma("unroll") for (int d_ = 0; d_ < 2; ++d_) _Pragma("unroll") for (int r = 0; r < 16; ++r) o[d_][r] *= wsf[crow(r, hi)]; } } while (0)
    f32x16 pA0, pA1, pB0, pB1;
    int sl_prev = s0, sl_cur = s0, sl_next = s1;
#define ROT() do { sl_prev = sl_cur; sl_cur = sl_next; sl_next = (sl_next == (NSLOT - 1) * SLOTB) ? 0 : sl_next + SLOTB; } while (0)
#define CINIT(P0, P1, i) do { const int kt_ = NT - 1 - (i); \
        if constexpr (FOX) { const LAS float* cp_ = cbl + kt_ * KVBLK + 4 * hi; \
            _Pragma("unroll") for (int j_ = 0; j_ < 4; ++j_) { const f32x4 a_ = *(const LAS f32x4*)(cp_ + 8 * j_), b_ = *(const LAS f32x4*)(cp_ + 32 + 8 * j_); \
                _Pragma("unroll") for (int e_ = 0; e_ < 4; ++e_) { P0[4 * j_ + e_] = (cref - mhat) - a_[e_]; P1[4 * j_ + e_] = (cref - mhat) - b_[e_]; } } } \
        else { const float c_ = ((selmask >> (kt_ >> 2)) & 1u) ? -mhat : -INFINITY; \
            _Pragma("unroll") for (int r_ = 0; r_ < 16; ++r_) { P0[r_] = c_; P1[r_] = c_; } } } while (0)
#define CINIT_G(P0, P1, i, g) do { const int kt_ = NT - 1 - (i); \
        if constexpr (FOX) { const LAS float* cp_ = cbl + kt_ * KVBLK + 4 * hi + 8 * ((g) >> 1) + 2 * ((g) & 1); \
            const f32x2 a_ = *(const LAS f32x2*)(cp_), b_ = *(const LAS f32x2*)(cp_ + 32); \
            const float cm_ = cref - mhat; P0[2 * (g)] = cm_ - a_[0]; P0[2 * (g) + 1] = cm_ - a_[1]; P1[2 * (g)] = cm_ - b_[0]; P1[2 * (g) + 1] = cm_ - b_[1]; } \
        else { const float c_ = ((selmask >> (kt_ >> 2)) & 1u) ? -mhat : -INFINITY; P0[2 * (g)] = c_; P0[2 * (g) + 1] = c_; P1[2 * (g)] = c_; P1[2 * (g) + 1] = c_; } } while (0)
    if (pub >= 0) { asm volatile("s_waitcnt vmcnt(0)" ::: "memory"); if (lane == 0) __hip_atomic_fetch_add(prdy + pub, 1, __ATOMIC_RELAXED, __HIP_MEMORY_SCOPE_AGENT); }
    DMA_K(2, s2);
    WAIT_BAR(3);
    if constexpr (FOX) {
        const LAS float* wsa = (const LAS float*)(shm3 + LDS_WS); float X = wsa[63];
#pragma unroll
        for (int w = 1; w < NW; ++w) X = __builtin_fmaxf(X, wsa[w * 64 + 63]);
        const bool skip = (lane < 4 * qb) && (cbl[KVBLK * lane + KVBLK - 1] >= X);
        const int ns = __builtin_popcountll(__ballot(skip));
        NTU = NT - ns; NTU += NTU & 1;
        NTU = __builtin_amdgcn_readfirstlane(NTU);
    }
    CINIT(pA0, pA1, 0);
    {
        const char* kb = Kbase + s0 + hi * 1024 + r32 * 16;
#pragma unroll
        for (int d0 = 0; d0 < 4; ++d0) { const h8 b0 = *reinterpret_cast<const h8*>(kb + d0 * 2048); const h8 b1 = *reinterpret_cast<const h8*>(kb + d0 * 2048 + 512);
            pA0 = MF16(b0, qr[d0], pA0); pA1 = MF16(b1, qr[d0], pA1); }
    }
    asm volatile("s_nop 15\n\ts_nop 7" : "+v"(pA0), "+v"(pA1));
    cmask(pA0, pA1, 3, qrel, hi);
    { const float rm = rowmax(pA0, pA1); const float dl = __builtin_fmaxf(rm, FLOOR2); mhat = dl;
#pragma unroll
      for (int r = 0; r < 16; ++r) { pA0[r] = fsub_s(pA0[r], dl); pA1[r] = fsub_s(pA1[r], dl); }
#pragma unroll
      for (int r = 0; r < 16; ++r) pA0[r] = __builtin_amdgcn_exp2f(pA0[r]);
#pragma unroll
      for (int r = 0; r < 16; ++r) pA1[r] = __builtin_amdgcn_exp2f(pA1[r]); }
    WAIT_BAR(0);
    DMA_K(3, s0); DMA_V(1, s1);
    ROT();
    kload8(kf, kp0 + sl_cur);
    CINIT(pB0, pB1, 1);
    WAIT_BAR(2);
    s16x4 vlo[8], vhi[8]; u32x4 pw0, pw1, pw2, pw3;
#define PKW(P, B) pkh(P[B], P[B + 1])
#define PAF(k) __builtin_bit_cast(h8, pw##k)
#define VFR(i) __builtin_bit_cast(h8, (__attribute__((ext_vector_type(8))) short){vlo[i][0], vlo[i][1], vlo[i][2], vlo[i][3], vhi[i][0], vhi[i][1], vhi[i][2], vhi[i][3]})
#define PIN(x) asm volatile("" : "+v"(x))
#define MX3(a, b, c) __builtin_fmaxf(__builtin_fmaxf((a), (b)), (c))
#define GAPA(MF, A0, A1, A2, A3, W0, W1, PW) do { MF; sacc += A0; sacc += A1; sacc += A2; sacc += A3; PIN(sacc); W0; W1; PIN(PW); SBAR(); } while (0)
#define EX(v) __builtin_amdgcn_exp2f(v)
#define GAPB(MF, X, B) do { MF; X[B] = EX(X[B]); X[B + 1] = EX(X[B + 1]); X[B + 2] = EX(X[B + 2]); X[B + 3] = EX(X[B + 3]); PIN(X); SBAR(); } while (0)
#define VRD(i) do { vlo[i] = vtr(vp_ + (((i) >> 2) * 4096 + ((i) & 3) * 1024)); vhi[i] = vtr(vp_ + (((i) >> 2) * 4096 + ((i) & 3) * 1024 + 512)); } while (0)
#define KRD(G, j) do { if (G) { kload2(kf, kp0 + sl_next, j); SBAR(); } } while (0)
#define STEP(C0, C1, P0, P1, t, GK, GV, GL, MASKED) do { SBAR(); \
    const lds_cptr vp_ = vp0 + sl_prev; \
    VRD(0); SBAR(); float sacc = (P0[0] + P0[1]); \
    GAPA(C0 = MF16(kf[0], qr[0], C0), P0[2], P0[3], P0[4], P0[5],     pw0[0] = PKW(P0, 0), pw0[1] = PKW(P0, 2), pw0); \
    VRD(4); SBAR(); GAPA(C1 = MF16(kf[1], qr[0], C1), P0[6], P0[7], P0[8], P0[9],     pw0[2] = PKW(P0, 4), pw0[3] = PKW(P0, 6), pw0); \
    VRD(1); SBAR(); GAPA(C0 = MF16(kf[2], qr[1], C0),   P0[10], P0[11], P0[12], P0[13], pw1[0] = PKW(P0, 8), pw1[1] = PKW(P0, 10), pw1); \
    VRD(5); SBAR(); GAPA(C1 = MF16(kf[3], qr[1], C1),   P0[14], P0[15], P1[0], P1[1],   pw1[2] = PKW(P0, 12), pw1[3] = PKW(P0, 14), pw1); \
    VRD(2); SBAR(); GAPA(C0 = MF16(kf[4], qr[2], C0),   P1[2], P1[3], P1[4], P1[5],     pw2[0] = PKW(P1, 0), pw2[1] = PKW(P1, 2), pw2); \
    VRD(6); SBAR(); GAPA(C1 = MF16(kf[5], qr[2], C1),   P1[6], P1[7], P1[8], P1[9],     pw2[2] = PKW(P1, 4), pw2[3] = PKW(P1, 6), pw2); \
    VRD(3); SBAR(); GAPA(C0 = MF16(kf[6], qr[3], C0),   P1[10], P1[11], P1[12], P1[13], pw3[0] = PKW(P1, 8), pw3[1] = PKW(P1, 10), pw3); \
    VRD(7); SBAR(); GAPA(C1 = MF16(kf[7], qr[3], C1),   P1[14], P1[15], 0.f, 0.f,       pw3[2] = PKW(P1, 12), pw3[3] = PKW(P1, 14), pw3); \
    l_reg += sacc; \
    if (GK) { DMA_K((t) + 3, sl_cur); } if (GV) { DMA_V((t) + 1, sl_next); } \
    if (MASKED) { if ((t) < 4) cmask(C0, C1, 3 - (t), qrel, hi); } \
    { float a = MX3(C0[0], C0[1], C1[0]), b = MX3(C0[2], C0[3], C1[1]); a = MX3(a, C1[2], C1[3]); \
      _Pragma("unroll") for (int r = 4; r < 16; r += 4) { a = MX3(a, C0[r], C0[r + 1]); b = MX3(b, C0[r + 2], C0[r + 3]); a = MX3(a, C1[r], C1[r + 1]); b = MX3(b, C1[r + 2], C1[r + 3]); } \
      float rm = __builtin_fmaxf(a, b); { auto rr = __builtin_amdgcn_permlane32_swap(__float_as_uint(rm), __float_as_uint(rm), false, false); rm = __builtin_fmaxf(__uint_as_float(rr[0]), __uint_as_float(rr[1])); } \
      resc = false; \
      if (__builtin_expect(__any(rm > (float)THRL), 0)) { const float dl = __builtin_fmaxf(rm, 0.f); mhat += dl; \
        _Pragma("unroll") for (int r = 0; r < 16; ++r) { C0[r] -= dl; C1[r] -= dl; } \
        const float f = __builtin_amdgcn_exp2f(-dl); l_reg *= f; if (hi == 0) wsf[r32] = f; resc = true; } } \
    SBAR(); \
    GAPB(o[0] = MF16(PAF(0), VFR(0), o[0]), C0, 0); if (GL) { CINIT_G(P0, P1, (t) + 1, 0); } \
    GAPB(o[1] = MF16(PAF(0), VFR(4), o[1]), C0, 4); if (GL) { CINIT_G(P0, P1, (t) + 1, 1); } \
    KRD(GL, 0); GAPB(o[0] = MF16(PAF(1), VFR(1), o[0]), C0, 8); if (GL) { CINIT_G(P0, P1, (t) + 1, 2); } \
    KRD(GL, 1); GAPB(o[1] = MF16(PAF(1), VFR(5), o[1]), C0, 12); if (GL) { CINIT_G(P0, P1, (t) + 1, 3); } \
    KRD(GL, 2); GAPB(o[0] = MF16(PAF(2), VFR(2), o[0]), C1, 0); if (GL) { CINIT_G(P0, P1, (t) + 1, 4); } \
    KRD(GL, 3); GAPB(o[1] = MF16(PAF(2), VFR(6), o[1]), C1, 4); if (GL) { CINIT_G(P0, P1, (t) + 1, 5); } \
    GAPB(o[0] = MF16(PAF(3), VFR(3), o[0]), C1, 8); if (GL) { CINIT_G(P0, P1, (t) + 1, 6); } \
    GAPB(o[1] = MF16(PAF(3), VFR(7), o[1]), C1, 12); if (GL) { CINIT_G(P0, P1, (t) + 1, 7); } \
    } while (0)
#define ENDW(tt) do { if ((tt) + 3 < NTU) { WAIT_BAR(2); } else if ((tt) + 2 < NTU) { WAIT_BAR(1); } else { WAIT_BAR(0); } } while (0)
    int t = 1;
    for (; t < 5 && t + 1 < NTU; t += 2) {
        STEP(pB0, pB1, pA0, pA1, t, (t + 3 < NTU), (t + 1 < NTU), (t + 1 < NTU), true);         ENDW(t);     RESC(); ROT();
        STEP(pA0, pA1, pB0, pB1, t + 1, (t + 4 < NTU), (t + 2 < NTU), (t + 2 < NTU), true);     ENDW(t + 1); RESC(); ROT();
    }
    for (; t + 5 < NTU; t += 2) {
        STEP(pB0, pB1, pA0, pA1, t, true, true, true, false);     WAIT_BAR(2); RESC(); ROT();
        STEP(pA0, pA1, pB0, pB1, t + 1, true, true, true, false); WAIT_BAR(2); RESC(); ROT();
    }
    for (; t + 1 < NTU; t += 2) {
        STEP(pB0, pB1, pA0, pA1, t, (t + 3 < NTU), (t + 1 < NTU), (t + 1 < NTU), false);         ENDW(t);     RESC(); ROT();
        STEP(pA0, pA1, pB0, pB1, t + 1, (t + 4 < NTU), (t + 2 < NTU), (t + 2 < NTU), false);     ENDW(t + 1); RESC(); ROT();
    }
    const int s0_next = sl_next;
    if (nx.valid) { const int nNT = 4 * nx.qb + 4;
        const size_t nhb = ((size_t)nx.b * NH + nx.h) * SEQ * KP;
        const half_t* nks = nx.K + nhb + ((long)(nNT - 1) * KVBLK + lane) * KP + wid * 8;
        const half_t* nvs = nx.V + nhb + ((long)(nNT - 1) * KVBLK + 16 * (wid & 3) + (lane >> 2)) * KP + (wid >> 2) * 32 + (lane & 3) * 8;
        glds16(nks, (unsigned)__builtin_amdgcn_readfirstlane(kdst + sl_next)); glds16(nvs, (unsigned)__builtin_amdgcn_readfirstlane(vdst + sl_next));
        glds16(nks - (long)KVBLK * KP, (unsigned)__builtin_amdgcn_readfirstlane(kdst + sl_prev)); }
    STEP(pB0, pB1, pA0, pA1, NTU - 1, false, false, false, true); RESC();
    { float sacc = pB0[0] + pB0[1];
#pragma unroll
      for (int r = 2; r < 16; ++r) sacc += pB0[r];
#pragma unroll
      for (int r = 0; r < 16; ++r) sacc += pB1[r];
      l_reg += sacc;
      pw0 = (u32x4){PKW(pB0, 0), PKW(pB0, 2), PKW(pB0, 4), PKW(pB0, 6)}; pw1 = (u32x4){PKW(pB0, 8), PKW(pB0, 10), PKW(pB0, 12), PKW(pB0, 14)};
      pw2 = (u32x4){PKW(pB1, 0), PKW(pB1, 2), PKW(pB1, 4), PKW(pB1, 6)}; pw3 = (u32x4){PKW(pB1, 8), PKW(pB1, 10), PKW(pB1, 12), PKW(pB1, 14)};
      SBAR(); pv(o, vb0 + sl_cur, PAF(0), PAF(1), PAF(2), PAF(3)); }
#undef PKW
#undef PAF
#undef VFR
#undef PIN
#undef MX3
#undef GAPA
#undef GAPB
#undef EX
#undef VRD
#undef KRD
#undef STEP
#undef ENDW
    { auto rr = __builtin_amdgcn_permlane32_swap(__float_as_uint(l_reg), __float_as_uint(l_reg), false, false); l_reg = __uint_as_float(rr[0]) + __uint_as_float(rr[1]); }
    int tide = threadIdx.x; asm volatile("" : "+v"(tide));
    const int lanee = tide & 63, r32e = lanee & 31, hie = lanee >> 5;
    float* wsfe = (float*)(shm + LDS_WS) + wid * 64;
    if (hie == 0) { wsfe[32 + r32e] = l_reg; if constexpr (MERGE) wsfe[r32e] = mhat; } asm volatile("s_waitcnt lgkmcnt(0)" ::: "memory");
    float rli[16];
#pragma unroll
    for (int r = 0; r < 16; ++r) rli[r] = __builtin_amdgcn_rcpf(wsfe[32 + crow(r, hie)]);
    const long grow0 = (long)b * SEQ + qb * QB + wid * QBLK;
    f32x2 pm[4][3]; h8 po[4][3]; const int nsel = qb < 3 ? qb : 3;
    if constexpr (MERGE) {
#pragma unroll
        for (int i = 0; i < 4; ++i) { const size_t pb = ((size_t)(grow0 + i * 8 + (lanee >> 3)) * NH + h) * 3;
#pragma unroll
            for (int k = 0; k < 3; ++k) { if (k < nsel) { pm[i][k] = *(const f32x2*)(partml + (pb + k) * 2); po[i][k] = *(const h8*)(parto + (pb + k) * HD + (lanee & 7) * 8); }
                                          else { pm[i][k] = (f32x2){-INFINITY, 0.f}; po[i][k] = h8{}; } } }
    }
    const __amdgpu_buffer_rsrc_t orsrc = __builtin_amdgcn_make_buffer_rsrc((void*)O, 0, 0x7fffffff, 0x00020000);
    { half_t* stg = (half_t*)(shm + LDS_OST) + wid * 2048;
#pragma unroll
      for (int r = 0; r < 16; ++r) { const int orow = crow(r, hie);
#pragma unroll
          for (int d0 = 0; d0 < 2; ++d0) stg[orow * 64 + d0 * 32 + r32e] = (half_t)(o[d0][r] * rli[r]); }
      asm volatile("s_waitcnt lgkmcnt(0)" ::: "memory");
#pragma unroll
      for (int i = 0; i < 4; ++i) { const int row = i * 8 + (lanee >> 3), ch = lanee & 7; u32x4 v = *(const u32x4*)(stg + row * 64 + ch * 8);
          if constexpr (MERGE) {
              const float m0 = wsfe[row], l0 = wsfe[32 + row]; float M = m0;
#pragma unroll
              for (int k = 0; k < 3; ++k) M = __builtin_fmaxf(M, pm[i][k][0]);
              const float w0 = l0 * __builtin_amdgcn_exp2f(m0 - M); float W = w0, wk[3];
#pragma unroll
              for (int k = 0; k < 3; ++k) { wk[k] = pm[i][k][1] * __builtin_amdgcn_exp2f(pm[i][k][0] - M); W += wk[k]; }
              const float iW = __builtin_amdgcn_rcpf(W); const h8 ov = __builtin_bit_cast(h8, v); float acc[8];
#pragma unroll
              for (int e = 0; e < 8; ++e) acc[e] = (float)ov[e] * w0;
#pragma unroll
              for (int k = 0; k < 3; ++k)
#pragma unroll
                  for (int e = 0; e < 8; ++e) acc[e] += (float)po[i][k][e] * wk[k];
              v.x = pkh(acc[0] * iW, acc[1] * iW); v.y = pkh(acc[2] * iW, acc[3] * iW); v.z = pkh(acc[4] * iW, acc[5] * iW); v.w = pkh(acc[6] * iW, acc[7] * iW);
          }
          __builtin_amdgcn_raw_buffer_store_b128(v, orsrc, (unsigned)(((grow0 + row) * OP + h * HD + ch * 8) * 2), 0, 16);
          const h8 hv = __builtin_bit_cast(h8, v); float sq = 0.f;
#pragma unroll
          for (int j = 0; j < 8; ++j) { const float f = (float)hv[j]; sq += f * f; }
          sq += __shfl_xor(sq, 1); sq += __shfl_xor(sq, 2); sq += __shfl_xor(sq, 4);
          if (ch == 0) __hip_atomic_store(ssq + (size_t)(grow0 + row) * 16 + h, sq, __ATOMIC_RELAXED, __HIP_MEMORY_SCOPE_AGENT); } }
    pub = b * NBLK + qb;
    asm volatile("s_waitcnt lgkmcnt(0)\n\ts_barrier" ::: "memory");
#undef DMA_K
#undef DMA_V
#undef RESC
#undef ROT
#undef CINIT
#undef CINIT_G
    return s0_next;
}
#undef SBAR
#undef WAIT_BAR
#undef MF16
}

namespace att {
#define SBAR() __builtin_amdgcn_sched_barrier(0)
#define MF16(a, b, c) __builtin_amdgcn_mfma_f32_32x32x16_f16(a, b, c, 0, 0, 0)
constexpr int BLK_K = 0, BLK_V = 32768, BLK_WS = 65536, BLK_OST = BLK_WS + NW * 512, BLK_END = BLK_OST + NW * 4096;
constexpr int LQCAP = 4096;

__device__ __forceinline__ void moba_gate(const half_t* __restrict__ QKV, const float* ksum, int* cntq, int* lq, int gt, int NGT, int lane) {
    for (int idx = gt; idx < BATCH * NH * SEQ; idx += NGT) {
        const int r = idx & 255, i = (idx >> 8) & 15, bh = idx >> 12, b = bh >> 3, h = bh & 7, t = i * 256 + r;
        if (i == 0) continue;
        const h8* qp = (const h8*)(QKV + ((size_t)b * SEQ + t) * NQKV + 1536 + h * HD);
        float q[64];
#pragma unroll
        for (int c = 0; c < 8; ++c) { const h8 v = qp[c];
#pragma unroll
            for (int e = 0; e < 8; ++e) q[c * 8 + e] = (float)v[e]; }
        float v0 = -INFINITY, v1 = -INFINITY, v2 = -INFINITY; int i0 = 31, i1 = 31, i2 = 31;
        float kvs[15];
#pragma unroll
        for (int n = 0; n < 15; ++n) kvs[n] = (n < i) ? ksum[((size_t)(b * NBLK + n)) * 512 + h * HD + lane] : 0.f;
#pragma unroll
        for (int n = 0; n < 15; ++n) { if (n < i) {
            float s = 0.f;
#pragma unroll
            for (int d = 0; d < 64; ++d) s += q[d] * __builtin_bit_cast(float, __builtin_amdgcn_readlane(__builtin_bit_cast(int, kvs[n]), d));
            const bool g0 = s > v0, g1 = s > v1, g2 = s > v2;
            v2 = g1 ? v1 : (g2 ? s : v2); i2 = g1 ? i1 : (g2 ? n : i2);
            v1 = g0 ? v0 : (g1 ? s : v1); i1 = g0 ? i0 : (g1 ? n : i1);
            v0 = g0 ? s : v0; i0 = g0 ? n : i0;
        } }
        int mycnt = 0, r0 = 0, r1 = 0, r2 = 0; const unsigned long long lt = (1ull << lane) - 1ull;
#pragma unroll 1
        for (int j = 0; j < i; ++j) {
            const bool s0 = (i0 == j), s1 = (i1 == j), s2 = (i2 == j);
            const unsigned long long mk = __ballot(s0 || s1 || s2);
            const int rk = __builtin_popcountll(mk & lt);
            mycnt = (lane == j) ? __builtin_popcountll(mk) : mycnt;
            r0 = s0 ? rk : r0; r1 = s1 ? rk : r1; r2 = s2 ? rk : r2;
        }
        int base = 0;
        if (lane < i && mycnt > 0) base = atomicAdd(cntq + bh * NBLK + lane, mycnt);
        const int b0 = __shfl(base, i0 & 63), b1 = __shfl(base, i1 & 63), b2 = __shfl(base, i2 & 63);
        if (i0 < i) lq[(size_t)(bh * NBLK + i0) * LQCAP + b0 + r0] = t * 4 + 0;
        if (i1 < i) lq[(size_t)(bh * NBLK + i1) * LQCAP + b1 + r1] = t * 4 + 1;
        if (i2 < i) lq[(size_t)(bh * NBLK + i2) * LQCAP + b2 + r2] = t * 4 + 2;
    }
}

template <bool OWN>
__device__ __forceinline__ void block_unit(int b, int h, int kblk, const int* __restrict__ lqp, int row_lo, int row_hi,
                                           const half_t* __restrict__ Q, const half_t* __restrict__ K, const half_t* __restrict__ V,
                                           half_t* parto, float* partml, half_t* O, float* ssq, char* shm) {
    int tid_ = threadIdx.x; asm volatile("" : "+v"(tid_));
    const int tid = tid_, lane = tid & 63, r32 = lane & 31, hi = lane >> 5; const int wid = __builtin_amdgcn_readfirstlane(tid >> 6);
    const long rowbase = (long)b * SEQ;
    const half_t* Kh = K + rowbase * QP + h * HD; const half_t* Vh = V + rowbase * QP + h * HD;
    const unsigned lds0 = (unsigned)(uintptr_t)shm; const lds_cptr shm3 = (lds_cptr)shm;
    {
        const half_t* ksrc = Kh + ((long)kblk * MBLK + lane) * QP + wid * 8;
        const half_t* vsrc = Vh + ((long)kblk * MBLK + 16 * (wid & 3) + (lane >> 2)) * QP + (wid >> 2) * 32 + (lane & 3) * 8;
        const unsigned kdst = lds0 + BLK_K + wid * 1024, vdst = lds0 + BLK_V + wid * 1024;
#pragma unroll
        for (int t4 = 0; t4 < 4; ++t4) { glds16(ksrc + (long)t4 * KVBLK * QP, (unsigned)__builtin_amdgcn_readfirstlane(kdst + t4 * 8192)); glds16(vsrc + (long)t4 * KVBLK * QP, (unsigned)__builtin_amdgcn_readfirstlane(vdst + t4 * 8192)); }
    }
    float* wsf = (float*)(shm + BLK_WS) + wid * 128;
    const int nchunk = OWN ? NW : ((row_hi - row_lo + 31) >> 5);
    const int ntw = OWN ? (wid >> 1) + 1 : 4;
    asm volatile("s_waitcnt vmcnt(0)\n\ts_barrier" ::: "memory");
    for (int c = wid; c < nchunk; c += NW) {
        int tq, kslot = 0; bool valid = true;
        if constexpr (OWN) { tq = kblk * MBLK + wid * QBLK + r32; }
        else { const int ix = row_lo + 32 * c + r32; valid = ix < row_hi; const int e = lqp[valid ? ix : row_lo]; tq = e >> 2; kslot = e & 3; }
        const half_t* qp = Q + (rowbase + tq) * QP + h * HD + hi * 8;
        h8 qr[4];
#pragma unroll
        for (int d0 = 0; d0 < 4; ++d0) qr[d0] = *reinterpret_cast<const h8*>(qp + d0 * 16);
        f32x16 p[4][2];
#pragma unroll
        for (int t4 = 0; t4 < 4; ++t4) { p[t4][0] = f32x16{}; p[t4][1] = f32x16{};
            if (t4 < ntw) {
                const lds_cptr kp = shm3 + BLK_K + t4 * 8192 + hi * 1024 + r32 * 16;
#pragma unroll
                for (int d0 = 0; d0 < 4; ++d0) { const h8 k0 = *(const LAS h8*)(kp + d0 * 2048), k1 = *(const LAS h8*)(kp + d0 * 2048 + 512);
                    p[t4][0] = MF16(k0, qr[d0], p[t4][0]); p[t4][1] = MF16(k1, qr[d0], p[t4][1]); }
                if constexpr (OWN) cmask(p[t4][0], p[t4][1], t4, wid * QBLK + r32, hi);
            } }
        float m = -INFINITY;
#pragma unroll
        for (int t4 = 0; t4 < 4; ++t4) if (t4 < ntw) {
#pragma unroll
            for (int r = 0; r < 16; ++r) m = __builtin_fmaxf(m, __builtin_fmaxf(p[t4][0][r], p[t4][1][r])); }
        { auto rr = __builtin_amdgcn_permlane32_swap(__float_as_uint(m), __float_as_uint(m), false, false); m = __builtin_fmaxf(__uint_as_float(rr[0]), __uint_as_float(rr[1])); }
        float l = 0.f;
#pragma unroll
        for (int t4 = 0; t4 < 4; ++t4) if (t4 < ntw) {
#pragma unroll
            for (int r = 0; r < 16; ++r) { p[t4][0][r] = __builtin_amdgcn_exp2f(p[t4][0][r] - m); p[t4][1][r] = __builtin_amdgcn_exp2f(p[t4][1][r] - m); l += p[t4][0][r] + p[t4][1][r]; } }
        { auto rr = __builtin_amdgcn_permlane32_swap(__float_as_uint(l), __float_as_uint(l), false, false); l = __uint_as_float(rr[0]) + __uint_as_float(rr[1]); }
        f32x16 o[2]; o[0] = f32x16{}; o[1] = f32x16{};
#pragma unroll
        for (int t4 = 0; t4 < 4; ++t4) if (t4 < ntw) {
            u32x4 pw0, pw1, pw2, pw3;
#define PKW(P, B) pkh(P[B], P[B + 1])
            pw0 = (u32x4){PKW(p[t4][0], 0), PKW(p[t4][0], 2), PKW(p[t4][0], 4), PKW(p[t4][0], 6)}; pw1 = (u32x4){PKW(p[t4][0], 8), PKW(p[t4][0], 10), PKW(p[t4][0], 12), PKW(p[t4][0], 14)};
            pw2 = (u32x4){PKW(p[t4][1], 0), PKW(p[t4][1], 2), PKW(p[t4][1], 4), PKW(p[t4][1], 6)}; pw3 = (u32x4){PKW(p[t4][1], 8), PKW(p[t4][1], 10), PKW(p[t4][1], 12), PKW(p[t4][1], 14)};
#undef PKW
            { const lds_cptr vp = shm3 + BLK_V + t4 * 8192 + ((lane >> 4) & 1) * 32 + (lane & 3) * 8 + (4 * hi + ((lane & 15) >> 2)) * 64;
              s16x4 vl[2][4], vh[2][4];
#pragma unroll
              for (int d0 = 0; d0 < 2; ++d0)
#pragma unroll
                  for (int ks = 0; ks < 4; ++ks) { vl[d0][ks] = vtr(vp + d0 * 4096 + ks * 1024); vh[d0][ks] = vtr(vp + d0 * 4096 + ks * 1024 + 512); }
#define VF(d, k) __builtin_bit_cast(h8, (__attribute__((ext_vector_type(8))) short){vl[d][k][0], vl[d][k][1], vl[d][k][2], vl[d][k][3], vh[d][k][0], vh[d][k][1], vh[d][k][2], vh[d][k][3]})
#pragma unroll
              for (int d0 = 0; d0 < 2; ++d0) { o[d0] = MF16(__builtin_bit_cast(h8, pw0), VF(d0, 0), o[d0]); o[d0] = MF16(__builtin_bit_cast(h8, pw1), VF(d0, 1), o[d0]);
                  o[d0] = MF16(__builtin_bit_cast(h8, pw2), VF(d0, 2), o[d0]); o[d0] = MF16(__builtin_bit_cast(h8, pw3), VF(d0, 3), o[d0]); }
#undef VF
            } }
        const int pidx = ((int)((rowbase + tq) * NH + h)) * 3 + kslot;
        if (hi == 0) { wsf[r32] = __builtin_amdgcn_rcpf(l); wsf[32 + r32] = m; wsf[64 + r32] = l; ((int*)wsf)[96 + r32] = valid ? pidx : -1; }
        asm volatile("s_waitcnt lgkmcnt(0)" ::: "memory");
        f32x2 pm[4][3]; h8 po[4][3]; int lr8 = lane >> 3, ch = lane & 7; const int nsel = kblk < 3 ? kblk : 3;
        if constexpr (OWN) {
            asm volatile("" : "+v"(lr8), "+v"(ch));
#pragma unroll
            for (int i = 0; i < 4; ++i) { const int trow = kblk * MBLK + wid * QBLK + i * 8 + lr8; const size_t pb = ((size_t)(rowbase + trow) * NH + h) * 3;
#pragma unroll
                for (int k = 0; k < 3; ++k) { if (k < nsel) { pm[i][k] = *(const f32x2*)(partml + (pb + k) * 2); po[i][k] = *(const h8*)(parto + (pb + k) * HD + ch * 8); }
                                              else { pm[i][k] = (f32x2){-INFINITY, 0.f}; po[i][k] = h8{}; } } }
        }
        half_t* stg = (half_t*)(shm + BLK_OST) + wid * 2048;
#pragma unroll
        for (int r = 0; r < 16; ++r) { const int orow = crow(r, hi); const float rl = wsf[orow];
#pragma unroll
            for (int d0 = 0; d0 < 2; ++d0) stg[orow * 64 + d0 * 32 + r32] = (half_t)(o[d0][r] * rl); }
        asm volatile("s_waitcnt lgkmcnt(0)" ::: "memory");
        if constexpr (!OWN) {
#pragma unroll
            for (int i = 0; i < 4; ++i) { const int row = i * 8 + (lane >> 3), ch = lane & 7; const u32x4 v = *(const u32x4*)(stg + row * 64 + ch * 8);
                const int dst = ((const int*)wsf)[96 + row];
                if (dst >= 0) { *(u32x4*)(parto + (size_t)dst * HD + ch * 8) = v; if (ch == 0) *(f32x2*)(partml + (size_t)dst * 2) = (f32x2){wsf[32 + row], wsf[64 + row]}; } }
        } else {
#pragma unroll
            for (int i = 0; i < 4; ++i) { const int row = i * 8 + lr8; const u32x4 v = *(const u32x4*)(stg + row * 64 + ch * 8);
                const int trow = kblk * MBLK + wid * QBLK + row;
                const float m0 = wsf[32 + row], l0 = wsf[64 + row];
                float M = m0;
#pragma unroll
                for (int k = 0; k < 3; ++k) M = __builtin_fmaxf(M, pm[i][k][0]);
                float w0 = l0 * __builtin_amdgcn_exp2f(m0 - M), W = w0; float wk[3];
#pragma unroll
                for (int k = 0; k < 3; ++k) { wk[k] = pm[i][k][1] * __builtin_amdgcn_exp2f(pm[i][k][0] - M); W += wk[k]; }
                const float iW = __builtin_amdgcn_rcpf(W);
                const h8 ov = __builtin_bit_cast(h8, v); float acc[8];
#pragma unroll
                for (int e = 0; e < 8; ++e) acc[e] = (float)ov[e] * w0;
#pragma unroll
                for (int k = 0; k < 3; ++k)
#pragma unroll
                    for (int e = 0; e < 8; ++e) acc[e] += (float)po[i][k][e] * wk[k];
                u32x4 w; float sq = 0.f; half_t hv[8];
#pragma unroll
                for (int e = 0; e < 8; ++e) { hv[e] = (half_t)(acc[e] * iW); const float f = (float)hv[e]; sq += f * f; }
                w.x = pkh((float)hv[0], (float)hv[1]); w.y = pkh((float)hv[2], (float)hv[3]); w.z = pkh((float)hv[4], (float)hv[5]); w.w = pkh((float)hv[6], (float)hv[7]);
                *(u32x4*)(O + (size_t)(rowbase + trow) * OP + h * HD + ch * 8) = w;
                sq += __shfl_xor(sq, 1); sq += __shfl_xor(sq, 2); sq += __shfl_xor(sq, 4);
                if (ch == 0) ssq[(size_t)(rowbase + trow) * 16 + h] = sq; }
        }
        asm volatile("s_waitcnt lgkmcnt(0)" ::: "memory");
    }
    asm volatile("s_waitcnt lgkmcnt(0)\n\ts_barrier" ::: "memory");
}
#undef SBAR
#undef MF16
}

constexpr int NWAVES = 8;
constexpr int NPHASE = 8;

struct Args {
    const float* in[16]; float* out; unsigned char* ws;
    double inv_freq[8];
    int ph_lo, ph_hi, li, pad;
};
struct Frame {
    LAS unsigned char* lds; int tid, lane, wave, vcu, G;
    const float *x, *norm_mix_g, *w_in, *b_forget, *fox_g, *moba_g, *w_out, *norm_ffn_g, *wrg, *brg, *wre, *bre, *wg, *wu, *wd, *gfin;
    float* out; unsigned char* ws;
};
#define LDS_WAIT() asm volatile("s_waitcnt lgkmcnt(0)" ::: "memory")

struct TItem { const float* src; const float* gs; half_t* dst; int spitch, K, drow0, k0, nt; float f8; };
__device__ __forceinline__ void p0_item_load(const TItem& t, f32x4 (&v)[8], int lane) {
    const int lr = lane >> 3, lc = (lane & 7) * 4;
#pragma unroll
    for (int i = 0; i < 8; ++i) v[i] = __builtin_nontemporal_load((const GAS f32x4*)(t.src + (size_t)(t.k0 + 8 * i + lr) * t.spitch + lc));
}
__device__ __forceinline__ void p0_item_finish(const TItem& t, f32x4 (&v)[8], LAS float* scr, int lane) {
    const int lr = lane >> 3, lc = (lane & 7) * 4;
    if (t.gs) {
#pragma unroll
        for (int i = 0; i < 8; ++i) v[i] = v[i] * t.gs[t.k0 + 8 * i + lr]; }
    if (t.f8 != 0.f) {
#pragma unroll
        for (int i = 0; i < 8; ++i) v[i] = v[i] * t.f8; }
#pragma unroll
    for (int i = 0; i < 8; ++i) { LAS float* s = scr + (8 * i + lr) * 33 + lc; s[0] = v[i][0]; s[1] = v[i][1]; s[2] = v[i][2]; s[3] = v[i][3]; }
    LDS_WAIT(); asm volatile("" ::: "memory");
    const int c = lane & 7;
#pragma unroll
    for (int j = 0; j < 4; ++j) { const int n = (lane >> 3) + 8 * j; const LAS float* s = scr + (8 * c) * 33 + n;
        if (t.f8 != 0.f) {
            float q[8];
#pragma unroll
            for (int e = 0; e < 8; ++e) q[e] = __builtin_fminf(__builtin_fmaxf(s[e * 33], -448.f), 448.f);
            int w0 = 0, w1 = 0;
            w0 = __builtin_amdgcn_cvt_pk_fp8_f32(q[0], q[1], w0, false); w0 = __builtin_amdgcn_cvt_pk_fp8_f32(q[2], q[3], w0, true);
            w1 = __builtin_amdgcn_cvt_pk_fp8_f32(q[4], q[5], w1, false); w1 = __builtin_amdgcn_cvt_pk_fp8_f32(q[6], q[7], w1, true);
            __builtin_nontemporal_store((u32x2){(unsigned)w0, (unsigned)w1}, (GAS u32x2*)((unsigned char*)t.dst + (size_t)(t.drow0 + n) * t.K + t.k0 + 8 * c));
            continue; }
        u32x4 o; o.x = pkh(s[0 * 33], s[1 * 33]); o.y = pkh(s[2 * 33], s[3 * 33]); o.z = pkh(s[4 * 33], s[5 * 33]); o.w = pkh(s[6 * 33], s[7 * 33]);
        GAS u32x4* dp = (GAS u32x4*)(t.dst + (size_t)(t.drow0 + n) * t.K + t.k0 + 8 * c);
        if (t.nt) __builtin_nontemporal_store(o, dp); else *dp = o; }
    LDS_WAIT(); asm volatile("" ::: "memory");
}
__device__ __forceinline__ float wave_sum8(const float (&d)[8], int lane) {
    const bool b5 = lane & 32, b4 = lane & 16, b3 = lane & 8;
    float u[4];
#pragma unroll
    for (int i = 0; i < 4; ++i) { const float keep = b5 ? d[4 + i] : d[i], give = b5 ? d[i] : d[4 + i]; u[i] = keep + __shfl_xor(give, 32); }
    float w[2];
#pragma unroll
    for (int i = 0; i < 2; ++i) { const float keep = b4 ? u[2 + i] : u[i], give = b4 ? u[i] : u[2 + i]; w[i] = keep + __shfl_xor(give, 16); }
    float z; { const float keep = b3 ? w[1] : w[0], give = b3 ? w[0] : w[1]; z = keep + __shfl_xor(give, 8); }
    z += __shfl_xor(z, 4); z += __shfl_xor(z, 2); z += __shfl_xor(z, 1);
    return z;
}
__device__ __forceinline__ void p0_prep(Frame& F, const Args& args) {
    unsigned char* ws = F.ws;
    half_t* W1T = (half_t*)(ws + WS_W1T); half_t* WOT = (half_t*)(ws + WS_WOT); half_t* WRT = (half_t*)(ws + WS_WRT); half_t* WGU = (half_t*)(ws + WS_WGU); half_t* WDT = (half_t*)(ws + WS_WD);
    half_t* XH = (half_t*)(ws + WS_XH); float* RSTD1 = (float*)(ws + WS_RSTD1); float* LOGF = (float*)(ws + WS_LOGF); float* KSUM = (float*)(ws + WS_KSUM);
    float2* ROPE = (float2*)(ws + WS_ROPE); int* CNT = (int*)(ws + WS_CNT);
    const int gw = F.vcu * NWAVES + F.wave, NGW = F.G * NWAVES; const int gt = F.vcu * 512 + F.tid, NGT = F.G * 512;
    for (int i = gt; i < BATCH * NBLK * 512; i += NGT) KSUM[i] = 0.f;
    if (gt < BATCH * 8 * 4) ((unsigned*)(ws + WS_NRM))[gt] = 0u;
    if (gt < 512) ((int*)(ws + WS_PRDY))[gt] = 0;
    if (gt < 2 * BATCH * NH * NBLK) ((int*)(ws + WS_CNTQ))[gt] = 0;
    for (int idx = gt; idx < SEQ * 8; idx += NGT) { const int s = idx >> 3, i = idx & 7; const double ang = (double)s * args.inv_freq[i]; const double TWO_PI = 6.283185307179586476925286766559;
        const double n = rint(ang / TWO_PI); const float r = (float)(ang - n * TWO_PI); ROPE[idx] = make_float2(cosf(r), sinf(r)); }
    for (int idx = gt; idx < 48 * DM; idx += NGT) { const int n = idx / DM, k = idx % DM; float v = 0.f;
        if (n < 4) v = F.wrg[(size_t)k * 4 + n] * F.norm_ffn_g[k]; else if (n < 36) v = F.wre[(size_t)k * 32 + (n - 4)] * F.norm_ffn_g[k];
        WRT[idx] = (half_t)v; }
    LAS float* wf = (LAS float*)(F.lds + 98304);
    for (int i = F.tid; i < 8 * DM; i += 512) { const int k = i >> 3, j = i & 7; wf[j * DM + k] = F.norm_mix_g[k] * F.w_in[(size_t)k * INC + 1536 + j]; }
    __syncthreads();
    LAS float* scr = (LAS float*)(F.lds + F.wave * 8704);
    constexpr int I_IN = 16 * 96, I_OUT = 16 * 32, I_GU = NEXP * 16 * 16, I_D = NEXP * 4 * 32, NITEMS = I_IN + I_OUT + I_GU + I_D;
    auto decode = [&](int r, TItem& t) {
        if (r < I_IN) { const int kb = r / 96, nb = r % 96, n0 = nb * 32; const bool isv = (n0 >= 1024 && n0 < 1536) || n0 >= 2560;
            if (isv) t = TItem{F.w_in + (n0 < 1536 ? n0 : n0 + 8), F.norm_mix_g, (half_t*)(ws + WS_WV8), INC, DM, n0 < 1536 ? n0 - 1024 : n0 - 2560 + 512, kb * 64, 0, 64.f};
            else t = TItem{F.w_in + (n0 < 1536 ? n0 : n0 + 8), F.norm_mix_g, W1T, INC, DM, n0, kb * 64, 0, 0.f};
            return; } r -= I_IN;
        if (r < I_OUT) { const int kb = r / 32, nb = r % 32, k0 = kb * 64; t = TItem{F.w_out + nb * 32, (k0 < 512 ? F.fox_g : F.moba_g - 512), WOT, DM, DM, nb * 32, k0, 0, 0.f}; return; } r -= I_OUT;
        if (r < I_GU) { const int e = r >> 8, q = r & 255, kb = q >> 4, nb = q & 15, drow = nb * 32;
            const int j = drow >> 8, rr = drow & 255; const bool up = rr >= 128; const int f0 = 128 * j + (rr & 127);
            t = TItem{(up ? F.wu : F.wg) + (size_t)e * DM * DEXP + f0, F.norm_ffn_g, (half_t*)((unsigned char*)WGU + (size_t)e * 512 * DM), DEXP, DM, drow, kb * 64, 1, 64.f}; return; } r -= I_GU;
        { const int e = r >> 7, q = r & 127, kb = q >> 5, nb = q & 31;
            t = TItem{F.wd + (size_t)e * DEXP * DM + nb * 32, nullptr, (half_t*)((unsigned char*)WDT + (size_t)e * DM * DEXP), DM, DEXP, nb * 32, kb * 64, 1, 32.f}; }
    };
#pragma unroll 1
    for (int st = 0; st < 2; ++st) {
    if (((F.wave & 1) == 0) == (st == 0)) {
    for (int it = gw; it < NITEMS; it += 2 * NGW) {
        TItem ta, tb; f32x4 va[8], vb[8]; const bool two = it + NGW < NITEMS;
        decode(it, ta); p0_item_load(ta, va, F.lane);
        if (two) { decode(it + NGW, tb); p0_item_load(tb, vb, F.lane); }
        p0_item_finish(ta, va, scr, F.lane);
        if (two) p0_item_finish(tb, vb, scr, F.lane);
    }
    } else {
    for (int m0 = gw; m0 < T; m0 += NGW) {
        f32x4 v[1][4];
#pragma unroll
        for (int j = 0; j < 4; ++j) v[0][j] = __builtin_nontemporal_load((const GAS f32x4*)(F.x + (size_t)m0 * DM) + F.lane + 64 * j);
#pragma unroll
        for (int r = 0; r < 1; ++r) {
            const int m = m0;
            asm volatile("" : "+v"(wf));
            float ss = 0.f; float d[8] = {0.f, 0.f, 0.f, 0.f, 0.f, 0.f, 0.f, 0.f};
#pragma unroll
            for (int j = 0; j < 4; ++j) ss += (v[r][j].x * v[r][j].x + v[r][j].y * v[r][j].y) + (v[r][j].z * v[r][j].z + v[r][j].w * v[r][j].w);
#pragma unroll
            for (int j = 0; j < 4; ++j)
#pragma unroll
                for (int jj = 0; jj < 8; ++jj) { const f32x4 w = *(const LAS f32x4*)(wf + jj * DM + 4 * (F.lane + 64 * j)); d[jj] += (v[r][j].x * w.x + v[r][j].y * w.y) + (v[r][j].z * w.z + v[r][j].w * w.w); }
            ss = wave_sum(ss);
            const float dv = wave_sum8(d, F.lane);
            const float rs = 1.0f / sqrtf(ss * (1.0f / DM) + EPS);
            GAS u32x2* o8 = (GAS u32x2*)(XH + (size_t)m * DM) + F.lane;
#pragma unroll
            for (int j = 0; j < 4; ++j) { u32x2 w; w.x = pkh(v[r][j].x, v[r][j].y); w.y = pkh(v[r][j].z, v[r][j].w); o8[64 * j] = w; }
            { GAS unsigned* x8 = (GAS unsigned*)(ws + WS_X8 + (size_t)m * DM) + F.lane;
#pragma unroll
              for (int j = 0; j < 4; ++j) { float q4[4] = {v[r][j].x, v[r][j].y, v[r][j].z, v[r][j].w};
#pragma unroll
                  for (int e = 0; e < 4; ++e) q4[e] = __builtin_fminf(__builtin_fmaxf(q4[e] * 16.0f, -448.f), 448.f);
                  int w8 = 0; w8 = __builtin_amdgcn_cvt_pk_fp8_f32(q4[0], q4[1], w8, false); w8 = __builtin_amdgcn_cvt_pk_fp8_f32(q4[2], q4[3], w8, true);
                  x8[64 * j] = (unsigned)w8; } }
            if ((F.lane & 7) == 0) {
                const int hh = F.lane >> 3;
                const float z = dv * rs + F.b_forget[hh];
                const float lf = fminf(z, 0.f) - log1pf(expf(-fabsf(z)));
                const int b = m / SEQ, s_ = m % SEQ;
                LOGF[((size_t)b * 8 + hh) * SEQ + s_] = lf;
                if (F.lane == 0) RSTD1[m] = rs;
            }
        }
    }
    } }
}

struct EpiQKV {
    static constexpr bool PERM = true, HAS_MID = false;
    half_t* QKV; const float* rstd1; const float2* rope; float* ksum; unsigned* nrm; float ascale;
    __device__ __forceinline__ void mid(f32x4 (&)[2][2][4][2], const pg8::GUnit&, int, int) const {}
    __device__ __forceinline__ void unit_begin(const pg8::GUnit&) const {}
    __device__ __forceinline__ void operator()(const f32x4 (&acc)[2][2][4][2], const pg8::GUnit& u, int wr, int wc, int fr, int fq) const {
        asm volatile("" : "+v"(fr), "+v"(fq));
        const int kind = u.pn >> 1;
        const float cs = (kind == 0 || kind == 3) ? C2 : 1.0f;
        const bool rot = (kind == 3 || kind == 4) && ((wc & 1) == 0);
        const int row0 = u.pm * 256 + wr * 64 + fr, col0 = u.pn * 256 + wc * 32 + 8 * fq;
        float csum[2][8];
#pragma unroll
        for (int bj = 0; bj < 2; ++bj)
#pragma unroll
            for (int e = 0; e < 8; ++e) csum[bj][e] = 0.f;
        float nmx[2] = {0.f, 0.f};
#pragma unroll
        for (int ai = 0; ai < 2; ++ai)
#pragma unroll
            for (int m = 0; m < 4; ++m) {
                const int row = row0 + ai * 128 + m * 16; const float rs = rstd1[row] * cs * ascale;
                half_t* rowp = QKV + ((((size_t)kind * BATCH + (row >> 12)) * NH + (u.pn & 1) * 4 + (wc >> 1)) * SEQ + (row & (SEQ - 1))) * HD + (wc & 1) * 32 + 8 * fq;
                f32x4 c0, s0, c1, s1;
                if (rot) { const f32x4* rp = (const f32x4*)(rope + (size_t)(row & (SEQ - 1)) * 8); const f32x4 t0 = rp[0], t1 = rp[1], t2 = rp[2], t3 = rp[3];
                    c0 = (f32x4){t0[0], t0[2], t1[0], t1[2]}; s0 = (f32x4){t0[1], t0[3], t1[1], t1[3]}; c1 = (f32x4){t2[0], t2[2], t3[0], t3[2]}; s1 = (f32x4){t2[1], t2[3], t3[1], t3[3]}; }
#pragma unroll
                for (int bj = 0; bj < 2; ++bj) {
                    f32x4 v0 = acc[ai][bj][m][0] * rs, v1 = acc[ai][bj][m][1] * rs;
                    if (rot) {
                        f32x4 p0, p1;
#pragma unroll
                        for (int e = 0; e < 4; ++e) { p0[e] = __shfl_xor(v0[e], 16); p1[e] = __shfl_xor(v1[e], 16); }
                        if (fq == 0) { v0 = v0 * c0 - p0 * s0; v1 = v1 * c1 - p1 * s1; }
                        else if (fq == 1) { v0 = v0 * c0 + p0 * s0; v1 = v1 * c1 + p1 * s1; }
                    }
                    if (kind == 4) {
#pragma unroll
                        for (int e = 0; e < 4; ++e) { csum[bj][e] += v0[e]; csum[bj][4 + e] += v1[e]; }
                    }
                    if (kind <= 1) { float s = (v0[0] * v0[0] + v0[1] * v0[1]) + (v0[2] * v0[2] + v0[3] * v0[3]) + (v1[0] * v1[0] + v1[1] * v1[1]) + (v1[2] * v1[2] + v1[3] * v1[3]);
                        s += __shfl_xor(s, 16); s += __shfl_xor(s, 32); nmx[bj] = fmaxf(nmx[bj], s); }
                    u32x4 w; w.x = pkh(v0[0], v0[1]); w.y = pkh(v0[2], v0[3]); w.z = pkh(v1[0], v1[1]); w.w = pkh(v1[2], v1[3]);
                    if (kind == 0 || kind == 3) __builtin_nontemporal_store(w, (u32x4*)(rowp + (size_t)bj * 2 * SEQ * HD));
                    else *(u32x4*)(rowp + (size_t)bj * 2 * SEQ * HD) = w;
                }
            }
        if (kind <= 1) {
#pragma unroll
            for (int bj = 0; bj < 2; ++bj) { float s = nmx[bj]; s = fmaxf(s, __shfl_xor(s, 1)); s = fmaxf(s, __shfl_xor(s, 2)); s = fmaxf(s, __shfl_xor(s, 4)); s = fmaxf(s, __shfl_xor(s, 8));
                const int head = (u.pn & 1) * 4 + bj * 2 + (wc >> 1);
                if (fr == 0 && fq == 0) atomicMax(nrm + (((u.pm >> 4) * 8 + head) * 2 + kind) * 2 + (wc & 1), __float_as_uint(s * 1.002f)); }
        }
        if (kind == 4) {
            float* kp = ksum + (size_t)u.pm * 512 + (u.pn - 8) * 256 + wc * 32 + 8 * fq;
#pragma unroll
            for (int bj = 0; bj < 2; ++bj)
#pragma unroll
                for (int e = 0; e < 8; ++e) { float s = csum[bj][e]; s += __shfl_xor(s, 1); s += __shfl_xor(s, 2); s += __shfl_xor(s, 4); s += __shfl_xor(s, 8);
                    if (fr == 0) atomicAdd(kp + bj * 128 + e, s); }
        }
    }
};

__device__ __forceinline__ void cumsum_seq(const float* lf, float* cb, int lane) {
    const f32x4* p = (const f32x4*)(lf + lane * 64); float tot = 0.f;
#pragma unroll
    for (int i = 0; i < 16; ++i) { const f32x4 v = p[i]; tot += (v[0] + v[1]) + (v[2] + v[3]); }
    float inc = tot;
#pragma unroll
    for (int o = 1; o < 64; o <<= 1) { const float n = __shfl_up(inc, o); if (lane >= o) inc += n; }
    float run = inc - tot;
    f32x4* q = (f32x4*)(cb + lane * 64);
#pragma unroll
    for (int i = 0; i < 16; ++i) { const f32x4 v = p[i]; f32x4 o; run += v[0]; o[0] = run * LOG2E; run += v[1]; o[1] = run * LOG2E; run += v[2]; o[2] = run * LOG2E; run += v[3]; o[3] = run * LOG2E; q[i] = o; }
}

struct EpiOut {
    static constexpr int PERM = 2; static constexpr bool HAS_MID = true;
    const float* x; half_t* h2; const float* ssq; LAS f32x2* rowf; unsigned char* h8q; half_t* h2o;
    __device__ __forceinline__ void rowscales(int row, float& rf, float& rm) const {
        const f32x4* sp = (const f32x4*)(ssq + (size_t)row * 16); const f32x4 a = sp[0], b = sp[1], c = sp[2], d = sp[3];
        rf = 1.0f / sqrtf(((a[0] + a[1]) + (a[2] + a[3]) + (b[0] + b[1]) + (b[2] + b[3])) * (1.0f / 512.0f) + EPS);
        rm = 1.0f / sqrtf(((c[0] + c[1]) + (c[2] + c[3]) + (d[0] + d[1]) + (d[2] + d[3])) * (1.0f / 512.0f) + EPS);
    }
    __device__ __forceinline__ void unit_begin(const pg8::GUnit& u) const {
        int t = threadIdx.x; asm volatile("" : "+v"(t));
        if (t < 256) { float rf, rm; rowscales(u.pm * 256 + t, rf, rm); rowf[u.par * 256 + t] = (f32x2){rf / rm, rm}; }
    }
    __device__ __forceinline__ void mid(f32x4 (&acc)[2][2][4][2], const pg8::GUnit& u, int wr, int fr) const {
        asm volatile("" : "+v"(fr));
#pragma unroll
        for (int ai = 0; ai < 2; ++ai)
#pragma unroll
            for (int m = 0; m < 4; ++m) { const float sc = rowf[u.par * 256 + ai * 128 + wr * 64 + m * 16 + fr][0];
#pragma unroll
                for (int bj = 0; bj < 2; ++bj)
#pragma unroll
                    for (int n = 0; n < 2; ++n) acc[ai][bj][m][n] *= sc; }
    }
    __device__ __forceinline__ void operator()(const f32x4 (&acc)[2][2][4][2], const pg8::GUnit& u, int wr, int wc, int fr, int fq) const {
        asm volatile("" : "+v"(fr), "+v"(fq));
        const int up = (fr >> 3) & 1, rb = fr & 7;
        const int rowb = u.pm * 256 + wr * 64, colB = u.pn * 256 + wc * 64 + 16 * fq;
#define XCH8(v) do { _Pragma("unroll") for (int e_ = 0; e_ < 4; ++e_) v[e_] = (unsigned)__builtin_amdgcn_update_dpp(0, (int)v[e_], 0x128, 0xf, 0xf, true); } while (0)
        u32x4 d0[2][4], d1[2][4];
#pragma unroll
        for (int ai = 0; ai < 2; ++ai)
#pragma unroll
            for (int m = 0; m < 4; ++m) { const half_t* p = h2 + (size_t)(rowb + ai * 128 + m * 16 + rb) * DM + colB + 8 * up;
                d0[ai][m] = *(const u32x4*)p; d1[ai][m] = *(const u32x4*)(p + 8 * DM); }
#pragma unroll
        for (int ai = 0; ai < 2; ++ai)
#pragma unroll
            for (int m = 0; m < 4; ++m) { const float rm = rowf[u.par * 256 + ai * 128 + wr * 64 + m * 16 + fr][1];
                u32x4 s = up ? d0[ai][m] : d1[ai][m]; XCH8(s);
                const h8 xlo = __builtin_bit_cast(h8, up ? s : d0[ai][m]), xhi = __builtin_bit_cast(h8, up ? d1[ai][m] : s);
                u32x4 wv[2]; int w8[4];
#pragma unroll
                for (int bj = 0; bj < 2; ++bj) { const h8 xh = bj ? xhi : xlo;
                    const f32x4 x0 = {(float)xh[0], (float)xh[1], (float)xh[2], (float)xh[3]}, x1 = {(float)xh[4], (float)xh[5], (float)xh[6], (float)xh[7]};
                    const f32x4 v0 = x0 + acc[ai][bj][m][0] * rm, v1 = x1 + acc[ai][bj][m][1] * rm;
                    wv[bj] = (u32x4){pkh(v0[0], v0[1]), pkh(v0[2], v0[3]), pkh(v1[0], v1[1]), pkh(v1[2], v1[3])};
                    float q[8];
#pragma unroll
                    for (int e = 0; e < 4; ++e) { q[e] = __builtin_fminf(__builtin_fmaxf(v0[e] * 4.0f, -448.f), 448.f); q[4 + e] = __builtin_fminf(__builtin_fmaxf(v1[e] * 4.0f, -448.f), 448.f); }
                    int w0 = 0, w1 = 0;
                    w0 = __builtin_amdgcn_cvt_pk_fp8_f32(q[0], q[1], w0, false); w0 = __builtin_amdgcn_cvt_pk_fp8_f32(q[2], q[3], w0, true);
                    w1 = __builtin_amdgcn_cvt_pk_fp8_f32(q[4], q[5], w1, false); w1 = __builtin_amdgcn_cvt_pk_fp8_f32(q[6], q[7], w1, true);
                    w8[2 * bj] = w0; w8[2 * bj + 1] = w1; }
                u32x4 t = up ? wv[0] : wv[1]; XCH8(t);
                half_t* po = h2o + (size_t)(rowb + ai * 128 + m * 16 + rb) * DM + colB + 8 * up;
                *(u32x4*)po = up ? t : wv[0]; *(u32x4*)(po + 8 * DM) = up ? wv[1] : t;
                *(u32x4*)(h8q + (size_t)(rowb + ai * 128 + m * 16 + fr) * DM + colB) = (u32x4){(unsigned)w8[0], (unsigned)w8[1], (unsigned)w8[2], (unsigned)w8[3]}; }
#undef XCH8
    }
};

struct OutOrder {
    static constexpr bool GATHER = false, DEFER = true;
    const char* A; const char* Bt; int* qs; int* prdy; volatile LAS int* slot; int x0; mutable int pend, qn;
    __device__ __forceinline__ int draw(int q) const { return __hip_atomic_fetch_add(qs + 32 * q, 1, __ATOMIC_RELAXED, __HIP_MEMORY_SCOPE_AGENT); }
    __device__ __forceinline__ void prefetch(int) const { if (threadIdx.x == 0) pend = draw(qn & 7); }
    __device__ __forceinline__ bool next(int i, pg8::GUnit& u) const {
        if (threadIdx.x == 0) {
            if (i == 0) { qn = x0 & 7; pend = draw(qn); }
            int q = qn & 7, nex = qn >> 8, k = pend;
            while (k >= 64 && nex < 7) { ++nex; q = (q + 1) & 7; k = draw(q); }
            qn = q | (nex << 8);
            const int U = (k < 64) ? ((((k >> 2) << 3) + q) << 2) + (k & 3) : 512;
            if (U < 512) { const int b_ = (U >> 2) & 7, c_ = (U >> 5) & 3, pos = U >> 7, qb = (pos == 0) ? 15 - c_ : (pos == 1) ? 8 + c_ : (pos == 2) ? 7 - c_ : c_;
                int* w = prdy + b_ * NBLK + qb; unsigned sp = 0;
                while (__hip_atomic_load(w, __ATOMIC_RELAXED, __HIP_MEMORY_SCOPE_AGENT) < 128) { __builtin_amdgcn_s_sleep(2); if (++sp > (1u << 22)) break; } }
            slot[i & 1] = U;
        }
        asm volatile("s_waitcnt lgkmcnt(0)" ::: "memory"); __builtin_amdgcn_s_barrier(); asm volatile("" ::: "memory");
        const int U = slot[i & 1]; if (U >= 512) return false;
        const int pn = U & 3, b = (U >> 2) & 7, c = (U >> 5) & 3, pos = U >> 7, qb = (pos == 0) ? 15 - c : (pos == 1) ? 8 + c : (pos == 2) ? 7 - c : c;
        u.pm = b * NBLK + qb; u.pn = pn; u.aux = 0; u.A = A + (size_t)u.pm * 256 * DM * 2; u.B = Bt + (size_t)pn * 256 * DM * 2; return true; }
    __device__ __forceinline__ unsigned aoff(const pg8::GUnit&, int row, int C, int K_) const { return (unsigned)(row * K_ + C) * 2u; }
};

__device__ __forceinline__ void p4_fill(Frame& F) {
    const half_t* WRT = (const half_t*)(F.ws + WS_WRT);
    for (int i = F.tid; i < 48 * 128; i += 512) { const int r = i >> 7, kc = i & 127; const u32x4 v = *(const u32x4*)(WRT + (size_t)r * DM + kc * 8);
        *(LAS u32x4*)(F.lds + r * 2048 + (((kc & ~15) | ((kc ^ r) & 15)) << 4)) = v; }
    __syncthreads();
}
__device__ __forceinline__ void p4_router(Frame& F) {
    unsigned char* ws = F.ws;
    const half_t* H2 = (const half_t*)(ws + WS_XH);
    TokInfo* TOK = (TokInfo*)(ws + WS_TOK); int* CNT = (int*)(ws + WS_CNT);
    int* LTOK = (int*)(ws + WS_LTOK); float* LRS = (float*)(ws + WS_LRS); float* LCW = (float*)(ws + WS_LCW);
    LAS int* hist = (LAS int*)(F.lds + LDSX_OFF + LX_HIST); LAS int* ebase = (LAS int*)(F.lds + LDSX_OFF + LX_EBASE);
    LAS float* lgw = (LAS float*)(F.lds + 98304 + F.wave * 3072);
    const int r16 = F.lane & 15, q = F.lane >> 4;
    const LAS unsigned char* wlds = F.lds;
    for (int rb = F.vcu; rb < T / 128; rb += F.G) {
        if (F.tid < 32) hist[F.tid] = 0;
        __syncthreads();
        const int row = rb * 128 + F.wave * 16 + r16;
        const half_t* hr = H2 + (size_t)row * DM + 8 * q;
        f32x4 acc0 = {0.f, 0.f, 0.f, 0.f}, acc1 = acc0, acc2 = acc0; float ss = 0.f;
        h8 av[32];
#pragma unroll
        for (int ks = 0; ks < 32; ++ks) av[ks] = *(const h8*)(hr + 32 * ks);
#pragma unroll
        for (int ks = 0; ks < 32; ++ks) {
            { float t = 0.f;
#pragma unroll
              for (int j = 0; j < 8; ++j) { const float xf = (float)av[ks][j]; t += xf * xf; }
              ss += t; }
            const int kc = 4 * ks + q;
            const LAS unsigned char* wb = wlds + r16 * 2048 + (((kc & ~15) | ((kc ^ r16) & 15)) << 4);
            const h8 b0 = *(const LAS h8*)(wb), b1 = *(const LAS h8*)(wb + 16 * 2048), b2 = *(const LAS h8*)(wb + 32 * 2048);
            acc0 = __builtin_amdgcn_mfma_f32_16x16x32_f16(av[ks], b0, acc0, 0, 0, 0);
            acc1 = __builtin_amdgcn_mfma_f32_16x16x32_f16(av[ks], b1, acc1, 0, 0, 0);
            acc2 = __builtin_amdgcn_mfma_f32_16x16x32_f16(av[ks], b2, acc2, 0, 0, 0);
        }
        ss += __shfl_xor(ss, 16); ss += __shfl_xor(ss, 32);
        const float rs = 1.0f / sqrtf(ss * (1.0f / DM) + EPS);
#pragma unroll
        for (int rg = 0; rg < 4; ++rg) { lgw[(4 * q + rg) * 48 + r16] = acc0[rg]; lgw[(4 * q + rg) * 48 + 16 + r16] = acc1[rg]; lgw[(4 * q + rg) * 48 + 32 + r16] = acc2[rg]; }
        LDS_WAIT(); asm volatile("" ::: "memory");
        int e1 = 0, e2 = 0, pl1 = 0, pl2 = 0; float w1 = 0.f, w2 = 0.f;
        if (F.lane < 16) {
            const LAS float* lr = lgw + F.lane * 48;
            float lg[4];
#pragma unroll
            for (int j = 0; j < 4; ++j) lg[j] = lr[j] * rs + F.brg[j];
            int gi = 0; float gm = lg[0];
#pragma unroll
            for (int j = 1; j < 4; ++j) if (lg[j] > gm) { gm = lg[j]; gi = j; }
            float gs = 0.f;
#pragma unroll
            for (int j = 0; j < 4; ++j) gs += expf(lg[j] - gm);
            const float gtop = 1.0f / gs;
            const LAS float* el = lr + 4 + gi * 8; const float* be = F.bre + gi * 8;
            float ev[8];
#pragma unroll
            for (int j = 0; j < 8; ++j) ev[j] = el[j] * rs + be[j];
            int i1 = 0; float m1 = ev[0];
#pragma unroll
            for (int j = 1; j < 8; ++j) if (ev[j] > m1) { m1 = ev[j]; i1 = j; }
            int i2 = -1; float m2 = -INFINITY;
#pragma unroll
            for (int j = 0; j < 8; ++j) if (j != i1 && ev[j] > m2) { m2 = ev[j]; i2 = j; }
            if (i2 < 0) { i2 = (i1 == 0) ? 1 : 0; m2 = ev[i2]; }
            const float x2e = expf(m2 - m1);
            w1 = gtop / (1.0f + x2e); w2 = gtop * x2e / (1.0f + x2e);
            e1 = gi * 8 + i1; e2 = gi * 8 + i2;
            pl1 = __hip_atomic_fetch_add(hist + e1, 1, __ATOMIC_RELAXED, __HIP_MEMORY_SCOPE_WORKGROUP); pl2 = __hip_atomic_fetch_add(hist + e2, 1, __ATOMIC_RELAXED, __HIP_MEMORY_SCOPE_WORKGROUP);
        }
        __syncthreads();
        if (F.tid < 32) ebase[F.tid] = atomicAdd(CNT + F.tid, hist[F.tid]);
        __syncthreads();
        if (F.lane < 16) {
            const int p1 = ebase[e1] + pl1, p2 = ebase[e2] + pl2;
            TokInfo ti; ti.e1 = e1; ti.e2 = e2; ti.w1 = w1; ti.w2 = w2; ti.rstd2 = rs; ti.pad0 = p1; ti.pad1 = p2; ti.pad2 = 0;
            TOK[row] = ti;
            LTOK[(size_t)e1 * T + p1] = row; LRS[(size_t)e1 * T + p1] = rs; LCW[(size_t)e1 * T + p1] = w1;
            LTOK[(size_t)e2 * T + p2] = row; LRS[(size_t)e2 * T + p2] = rs; LCW[(size_t)e2 * T + p2] = w2;
        }
        __syncthreads();
    }
}

__device__ __forceinline__ void moe_tile_table(Frame& F) {
    LAS int* toff = (LAS int*)(F.lds + LDSX_OFF + LX_TOFF); const int* CNT = (const int*)(F.ws + WS_CNT);
    if (F.wave == 0) {
        const int c = (F.lane < NEXP) ? ((__hip_atomic_load(CNT + (F.lane & 31), __ATOMIC_RELAXED, __HIP_MEMORY_SCOPE_AGENT) + 255) >> 8) : 0;
        int s = c;
#pragma unroll
        for (int o = 1; o < 32; o <<= 1) { const int n = __shfl_up(s, o); if (F.lane >= o) s += n; }
        if (F.lane < NEXP) toff[F.lane] = s - c;
        if (F.lane == NEXP - 1) toff[NEXP] = s;
    }
    __syncthreads();
    if (F.tid < 320) { int e = 0;
#pragma unroll
        for (int s = NEXP / 2; s; s >>= 1) e += (toff[e + s] <= F.tid) ? s : 0;
        ((LAS int*)(F.lds + LDSX_OFF + LX_TEXP))[F.tid] = e; }
    __syncthreads();
}
__device__ __forceinline__ int moe_find_expert(const LAS int* toff, int tile) { return ((const LAS int*)((const LAS unsigned char*)toff + (LX_TEXP - LX_TOFF)))[tile]; }
struct MoeUpOrder {
    static constexpr bool GATHER = true, DEFER = false;
    const char* H2; const char* WGU; const LAS int* toff; const LAS int* rtok; int G, c, nunits;
    __device__ __forceinline__ bool next(int i, pg8::GUnit& u) const {
        const int U = c + G * i; if (i >= MAXU || U >= nunits) return false;
        const int tile = U >> 1, j = U & 1, e = moe_find_expert(toff, tile);
        u.A = H2; u.B = WGU + ((size_t)e * 512 + (size_t)j * 256) * DM; u.pm = tile; u.pn = j; u.aux = i; return true; }
    __device__ __forceinline__ unsigned aoff(const pg8::GUnit& u, int row, int C, int K_) const { const int tok = rtok[u.aux * 256 + row]; return (unsigned)(tok * K_ + C) * 2u; }
};
struct EpiMoeUp {
    static constexpr bool PERM = true, HAS_MID = false;
    half_t* ACT; const LAS float* rrs; const LAS float* rcw; int* trdy;
    __device__ __forceinline__ void mid(f32x4 (&)[2][2][4][2], const pg8::GUnit&, int, int) const {}
    __device__ __forceinline__ void unit_begin(const pg8::GUnit&) const {}
    __device__ __forceinline__ void operator()(const f32x4 (&acc)[2][2][4][2], const pg8::GUnit& u, int wr, int wc, int fr, int fq) const {
        asm volatile("" : "+v"(fr), "+v"(fq));
        const __amdgpu_buffer_rsrc_t rsrc = __builtin_amdgcn_make_buffer_rsrc((void*)ACT, 0, 73728 * DEXP, 0x00020000);
#pragma unroll
        for (int ai = 0; ai < 2; ++ai)
#pragma unroll
            for (int m = 0; m < 4; ++m) { const int rl = ai * 128 + wr * 64 + m * 16 + fr; const float rs = rrs[u.aux * 256 + rl] * (1.0f / 256.0f), cw = rcw[u.aux * 256 + rl] * 8.0f;
                float o[8];
#pragma unroll
                for (int n = 0; n < 2; ++n)
#pragma unroll
                    for (int e = 0; e < 4; ++e) { const float a = acc[ai][0][m][n][e] * rs, up = acc[ai][1][m][n][e] * rs;
                        const float sg = __builtin_amdgcn_rcpf(1.0f + __builtin_amdgcn_exp2f(-a * LOG2E)); o[n * 4 + e] = a * sg * up * cw; }
#pragma unroll
                for (int e = 0; e < 8; ++e) o[e] = __builtin_fminf(__builtin_fmaxf(o[e], -448.f), 448.f);
                int w0 = 0, w1 = 0;
                w0 = __builtin_amdgcn_cvt_pk_fp8_f32(o[0], o[1], w0, false); w0 = __builtin_amdgcn_cvt_pk_fp8_f32(o[2], o[3], w0, true);
                w1 = __builtin_amdgcn_cvt_pk_fp8_f32(o[4], o[5], w1, false); w1 = __builtin_amdgcn_cvt_pk_fp8_f32(o[6], o[7], w1, true);
                __builtin_amdgcn_raw_buffer_store_b64((u32x2){(unsigned)w0, (unsigned)w1}, rsrc, (unsigned)((u.pm * 256 + rl) * DEXP + u.pn * 128 + wc * 32 + 8 * fq), 0, 16); }
        if (trdy) { asm volatile("s_waitcnt vmcnt(0)" ::: "memory");
        if ((threadIdx.x & 63) == 0) __hip_atomic_fetch_add(trdy + u.pm, 1, __ATOMIC_RELAXED, __HIP_MEMORY_SCOPE_AGENT); }
    }
};
struct MoeDownOrder {
    static constexpr bool GATHER = false, DEFER = true;
    const char* ACT; const char* WDT; const LAS int* toff; int* q6; int* trdy; volatile LAS int* slot; int nunits; mutable int tA, tB, tC, fA, fB;
    __device__ __forceinline__ int draw() const { return __hip_atomic_fetch_add(q6, 1, __ATOMIC_RELAXED, __HIP_MEMORY_SCOPE_AGENT); }
    __device__ __forceinline__ int flag(int U) const { return __hip_atomic_load(trdy + (U >> 2), __ATOMIC_RELAXED, __HIP_MEMORY_SCOPE_AGENT); }
    __device__ __forceinline__ void prefetch(int i) const {
        if (threadIdx.x == 0) {
            if (i > 1) { tA = tB; tB = tC; fA = fB; }
            tC = draw();
            fB = flag(tB);
        }
    }
    __device__ __forceinline__ bool next(int i, pg8::GUnit& u) const {
        if (threadIdx.x == 0) {
            int U, fl;
            if (i == 0) { U = draw(); tA = draw(); tB = draw(); fl = 0; fA = flag(tA); } else { U = tA; fl = fA; }
            if (U < nunits && fl < 16) { int* w = trdy + (U >> 2); unsigned sp = 0;
                while (__hip_atomic_load(w, __ATOMIC_RELAXED, __HIP_MEMORY_SCOPE_AGENT) < 16) { __builtin_amdgcn_s_sleep(2); if (++sp > (1u << 22)) break; }
            }
            slot[i & 1] = U;
        }
        asm volatile("s_waitcnt lgkmcnt(0)" ::: "memory"); __builtin_amdgcn_s_barrier(); asm volatile("" ::: "memory");
        const int U = slot[i & 1]; if (U >= nunits) return false;
        const int tile = U >> 2, pn = U & 3, e = moe_find_expert(toff, tile);
        u.A = ACT + (size_t)tile * 256 * DEXP; u.B = WDT + ((size_t)e * DM + (size_t)pn * 256) * DEXP; u.pm = tile; u.pn = pn; u.aux = 0; return true; }
    __device__ __forceinline__ unsigned aoff(const pg8::GUnit&, int row, int C, int K_) const { return (unsigned)(row * K_ + C) * 2u; }
};
struct EpiMoeDown {
    static constexpr int PERM = 2; static constexpr bool HAS_MID = false;
    half_t* Y;
    __device__ __forceinline__ void mid(f32x4 (&)[2][2][4][2], const pg8::GUnit&, int, int) const {}
    __device__ __forceinline__ void unit_begin(const pg8::GUnit&) const {}
    __device__ __forceinline__ void operator()(const f32x4 (&acc)[2][2][4][2], const pg8::GUnit& u, int wr, int wc, int fr, int fq) const {
        asm volatile("" : "+v"(fr), "+v"(fq));
        if (!Y) return;
#pragma unroll
        for (int ai = 0; ai < 2; ++ai)
#pragma unroll
            for (int m = 0; m < 4; ++m) { unsigned char* rowp = (unsigned char*)Y + ((size_t)u.pm * 256 + ai * 128 + wr * 64 + m * 16 + fr) * DM + u.pn * 256 + wc * 64 + 16 * fq;
                int w[4];
#pragma unroll
                for (int bj = 0; bj < 2; ++bj) { const f32x4 v0 = acc[ai][bj][m][0] * 0.0625f, v1 = acc[ai][bj][m][1] * 0.0625f;
                    int w0 = 0, w1 = 0;
                    w0 = __builtin_amdgcn_cvt_pk_fp8_f32(v0[0], v0[1], w0, false); w0 = __builtin_amdgcn_cvt_pk_fp8_f32(v0[2], v0[3], w0, true);
                    w1 = __builtin_amdgcn_cvt_pk_fp8_f32(v1[0], v1[1], w1, false); w1 = __builtin_amdgcn_cvt_pk_fp8_f32(v1[2], v1[3], w1, true);
                    w[2 * bj] = w0; w[2 * bj + 1] = w1; }
                *(u32x4*)rowp = (u32x4){(unsigned)w[0], (unsigned)w[1], (unsigned)w[2], (unsigned)w[3]}; }
    }
};

__device__ __forceinline__ void p7_final(Frame& F) {
    const LAS int* toff = (const LAS int*)(F.lds + LDSX_OFF + LX_TOFF);
    const TokInfo* TOK = (const TokInfo*)(F.ws + WS_TOK); const half_t* Y = (const half_t*)(F.ws + WS_Y); const half_t* H2 = (const half_t*)(F.ws + WS_XH);
    const int gw = F.vcu * NWAVES + F.wave, NGW = F.G * NWAVES;
    f32x4 g[4];
#pragma unroll
    for (int j = 0; j < 2; ++j) { g[2 * j] = *(const GAS f32x4*)(F.gfin + 8 * (F.lane + 64 * j)); g[2 * j + 1] = *(const GAS f32x4*)(F.gfin + 8 * (F.lane + 64 * j) + 4); }
    for (int m0 = gw; m0 < T; m0 += 16 * NGW) {
        int r1l = 0, r2l = 0;
        { const int mi = m0 + (F.lane & 15) * NGW; if (mi < T) { const TokInfo ti = TOK[mi]; r1l = toff[ti.e1] * 256 + ti.pad0; r2l = toff[ti.e2] * 256 + ti.pad1; } }
#pragma unroll 1
        for (int i = 0; i < 16; i += 1) {
            int mr[1]; size_t y1[1], y2[1]; bool ok[1];
#pragma unroll
            for (int r = 0; r < 1; ++r) { mr[r] = m0 + (i + r) * NGW; ok[r] = mr[r] < T; if (!ok[r]) mr[r] = m0;
                y1[r] = (size_t)__builtin_amdgcn_readlane(r1l, i + r); y2[r] = (size_t)__builtin_amdgcn_readlane(r2l, i + r); if (!ok[r]) { y1[r] = y1[0]; y2[r] = y2[0]; } }
            if (!ok[0]) break;
            h8 xv[1][2]; u32x2 yv[1][2], zv[1][2];
#pragma unroll
            for (int r = 0; r < 1; ++r)
#pragma unroll
                for (int j = 0; j < 2; ++j) { const int c = 8 * (F.lane + 64 * j);
                    xv[r][j] = __builtin_nontemporal_load((const GAS h8*)(H2 + (size_t)mr[r] * DM + c)); yv[r][j] = __builtin_nontemporal_load((const GAS u32x2*)((const unsigned char*)Y + y1[r] * DM + c)); zv[r][j] = __builtin_nontemporal_load((const GAS u32x2*)((const unsigned char*)Y + y2[r] * DM + c)); }
#pragma unroll
            for (int r = 0; r < 1; ++r) {
                float v[16]; float sq = 0.f;
#pragma unroll
                for (int j = 0; j < 2; ++j)
                    { const f32x2 y0 = __builtin_amdgcn_cvt_pk_f32_fp8((int)yv[r][j][0], false), y1_ = __builtin_amdgcn_cvt_pk_f32_fp8((int)yv[r][j][0], true), y2_ = __builtin_amdgcn_cvt_pk_f32_fp8((int)yv[r][j][1], false), y3 = __builtin_amdgcn_cvt_pk_f32_fp8((int)yv[r][j][1], true);
                      const f32x2 z0 = __builtin_amdgcn_cvt_pk_f32_fp8((int)zv[r][j][0], false), z1_ = __builtin_amdgcn_cvt_pk_f32_fp8((int)zv[r][j][0], true), z2_ = __builtin_amdgcn_cvt_pk_f32_fp8((int)zv[r][j][1], false), z3 = __builtin_amdgcn_cvt_pk_f32_fp8((int)zv[r][j][1], true);
                      const float yz[8] = {y0[0] + z0[0], y0[1] + z0[1], y1_[0] + z1_[0], y1_[1] + z1_[1], y2_[0] + z2_[0], y2_[1] + z2_[1], y3[0] + z3[0], y3[1] + z3[1]};
#pragma unroll
                      for (int e = 0; e < 8; ++e) { const float t = (float)xv[r][j][e] + yz[e] * 0.0625f; v[8 * j + e] = t; sq += t * t; } }
                sq = wave_sum(sq);
                const float rr = 1.0f / sqrtf(sq * (1.0f / DM) + EPS);
                if (ok[r]) {
#pragma unroll
                    for (int j = 0; j < 2; ++j) { const int c = 8 * (F.lane + 64 * j);
                        __builtin_nontemporal_store((f32x4){v[8 * j] * rr, v[8 * j + 1] * rr, v[8 * j + 2] * rr, v[8 * j + 3] * rr} * g[2 * j], (GAS f32x4*)(F.out + (size_t)mr[r] * DM + c));
                        __builtin_nontemporal_store((f32x4){v[8 * j + 4] * rr, v[8 * j + 5] * rr, v[8 * j + 6] * rr, v[8 * j + 7] * rr} * g[2 * j + 1], (GAS f32x4*)(F.out + (size_t)mr[r] * DM + c + 4)); } }
            }
        }
    }
}

#define XB_TMO      128
#define XB_XCNT(j)  (256  + 64 * (j))
#define XB_XSUB(j)  (1280 + 64 * (j))
#define XB_XGEN(j)  (2304 + 64 * (j))
#define XB_TOP      3328
#define XB_TOPGEN   3392
#define XCD_BAR_WORDS 3456
#define XB_SPIN_CAP (1u << 18)
__device__ __forceinline__ unsigned xb_ld(unsigned* p)              { return __hip_atomic_load(p, __ATOMIC_RELAXED, __HIP_MEMORY_SCOPE_AGENT); }
__device__ __forceinline__ unsigned xb_add(unsigned* p, unsigned v) { return __hip_atomic_fetch_add(p, v, __ATOMIC_RELAXED, __HIP_MEMORY_SCOPE_AGENT); }
__device__ __forceinline__ unsigned xb_xcc_id() { return (unsigned)__builtin_amdgcn_s_getreg((3 << 11) | 20) & 0xFu; }
#define XB_SPIN(cond, bar) do { unsigned _sp = 0; while (cond) { __builtin_amdgcn_s_sleep(1); \
    if ((++_sp & 255u) == 0u) { if (xb_ld(&(bar)[XB_TMO])) break; if (_sp > XB_SPIN_CAP) { atomicAdd(&(bar)[XB_TMO], 1u); break; } } } } while (0)
struct XcdBarrier { unsigned* bar; unsigned x; volatile LAS unsigned* st; };
__device__ __forceinline__ XcdBarrier xcd_barrier_post(unsigned* bar, volatile LAS unsigned* st) {
    XcdBarrier b; b.bar = bar; b.x = xb_xcc_id(); b.st = st;
    if (threadIdx.x == 0) (void)xb_add(&bar[XB_XCNT(b.x)], 1u);
    return b;
}
__device__ __forceinline__ void xcd_barrier_complete(unsigned* bar, unsigned x, unsigned& nloc, unsigned& nx) {
    const unsigned G = gridDim.x * gridDim.y * gridDim.z;
    unsigned sum, cnt, mine, sp = 0u;
    for (;;) {
        sum = 0u; cnt = 0u; mine = 0u;
#pragma unroll
        for (unsigned j = 0; j < 16; ++j) { const unsigned c = xb_ld(&bar[XB_XCNT(j)]); sum += c; cnt += (c > 0u) ? 1u : 0u; mine = (j == x) ? c : mine; }
        if (sum == G) break;
        __builtin_amdgcn_s_sleep(1);
        if ((++sp & 255u) == 0u) { if (xb_ld(&bar[XB_TMO])) break; if (sp > XB_SPIN_CAP) { atomicAdd(&bar[XB_TMO], 1u); break; } }
    }
    nloc = mine > 0u ? mine : 1u; nx = cnt > 0u ? cnt : 1u;
}
__device__ __forceinline__ void xcd_barrier(const XcdBarrier& b) {
    asm volatile("s_waitcnt vmcnt(0)" ::: "memory");
    __syncthreads();
    if (threadIdx.x == 0) {
        unsigned* bar = b.bar;
        __builtin_amdgcn_s_waitcnt(0);
        unsigned nloc = b.st[0], nx = b.st[1];
        if (nloc == 0u) { xcd_barrier_complete(bar, b.x, nloc, nx); b.st[0] = nloc; b.st[1] = nx; }
        const unsigned old = xb_add(&bar[XB_XSUB(b.x)], 1u);
        const unsigned gen = old / nloc;
        if (old + 1u == (gen + 1u) * nloc) {
            __builtin_amdgcn_fence(__ATOMIC_RELEASE, "agent");
            asm volatile("s_waitcnt vmcnt(0)" ::: "memory");
            const unsigned og = xb_add(&bar[XB_TOP], 1u);
            const unsigned tg = og / nx;
            if (og + 1u == (tg + 1u) * nx) xb_add(&bar[XB_TOPGEN], 1u);
            else XB_SPIN(xb_ld(&bar[XB_TOPGEN]) == tg, bar);
            __builtin_amdgcn_fence(__ATOMIC_ACQUIRE, "agent");
            xb_add(&bar[XB_XGEN(b.x)], 1u);
            asm volatile("s_waitcnt vmcnt(0)" ::: "memory");
        } else {
            XB_SPIN(xb_ld(&bar[XB_XGEN(b.x)]) == gen, bar);
            __builtin_amdgcn_fence(__ATOMIC_ACQUIRE, "agent");
            asm volatile("s_waitcnt vmcnt(0)" ::: "memory");
        }
    }
    __syncthreads();
}

__global__ void __launch_bounds__(NWAVES * 64, 2) fwd_mega(Args args) {
    extern __shared__ __attribute__((aligned(16))) unsigned char lds[];
    Frame F;
    F.lds = (LAS unsigned char*)lds; F.tid = threadIdx.x; F.lane = F.tid & 63; F.wave = __builtin_amdgcn_readfirstlane(F.tid >> 6);
    F.G = gridDim.x; { const int bx = blockIdx.x; F.vcu = (F.G % 8 == 0) ? (bx % 8) * (F.G / 8) + bx / 8 : bx; }
    F.x = args.in[0]; F.norm_mix_g = args.in[1]; F.w_in = args.in[2]; F.b_forget = args.in[3]; F.fox_g = args.in[4]; F.moba_g = args.in[5]; F.w_out = args.in[6]; F.norm_ffn_g = args.in[7];
    F.wrg = args.in[8]; F.brg = args.in[9]; F.wre = args.in[10]; F.bre = args.in[11]; F.wg = args.in[12]; F.wu = args.in[13]; F.wd = args.in[14]; F.gfin = args.in[15];
    F.out = args.out; F.ws = args.ws;
    unsigned char* ws = args.ws;
    if (F.tid < 16) ((LAS unsigned*)(F.lds + LDSX_OFF))[F.tid] = 0u;
    __syncthreads();
    XcdBarrier xbar = xcd_barrier_post((unsigned*)(ws + WS_CTL) + args.li * XCD_BAR_WORDS, (volatile LAS unsigned*)(F.lds + LDSX_OFF + 32));
    const int lo = args.ph_lo, hi = args.ph_hi;
#ifndef PROBE_MOBA
#define PROBE_MOBA 0
#endif
#ifndef MOBA_SPARSE_UNUSED
#define MOBA_SPARSE_UNUSED 1
#endif
#ifndef PHMASK
#define PHMASK 0xFF
#endif
#define IN(k) ((((PHMASK) >> (k)) & 1) && lo <= (k) && (k) < hi)
#define SEAM(k) do { if (IN(k) && IN((k) + 1)) xcd_barrier(xbar); } while (0)
#ifndef REPMASK
#define REPMASK 0x00
#endif
#define REP(k) for (int rep_ = 0; rep_ < 1 + (((REPMASK) >> (k)) & 1); ++rep_)
    half_t* QKV = (half_t*)(ws + WS_QKV); half_t* OB = (half_t*)(ws + WS_O);
    constexpr size_t KIND = (size_t)BATCH * NH * SEQ * HD;

    if (IN(0)) { REP(0) p0_prep(F, args); SEAM(0); }

    if (IN(1)) { REP(1) {
        if (F.vcu < 8) { const int seq = F.vcu * 8 + F.wave; cumsum_seq((const float*)(ws + WS_LOGF) + (size_t)seq * SEQ, (float*)(ws + WS_CB) + (size_t)seq * SEQ, F.lane); }
        { pg8::QkvOrder S; S.d.init(ws + WS_XH, ws + WS_W1T, T, 2048, DM, F.G, (int)blockIdx.x); S.mode = 0; S.Bbase = (const char*)(ws + WS_W1T);
          EpiQKV E{QKV, (const float*)(ws + WS_RSTD1), (const float2*)(ws + WS_ROPE), (float*)(ws + WS_KSUM), (unsigned*)(ws + WS_NRM), 1.0f};
          pg8::gemm_phase<EpiQKV, pg8::QkvOrder, true>(F.lds, DM, S, E); }
        { pg8::QkvOrder S; S.d.init(ws + WS_X8, ws + WS_WV8, T, 1024, DM / 2, F.G, (int)blockIdx.x); S.mode = 1; S.Bbase = (const char*)(ws + WS_WV8);
          EpiQKV E{QKV, (const float*)(ws + WS_RSTD1), (const float2*)(ws + WS_ROPE), (float*)(ws + WS_KSUM), (unsigned*)(ws + WS_NRM), 1.0f / 1024.0f};
          pg8::gemm_phase<EpiQKV, pg8::QkvOrder, true, true>(F.lds, DM / 2, S, E); } }
        SEAM(1);
    }

    if (IN(2)) {
        const float* CB = (const float*)(ws + WS_CB); const float* KSUM = (const float*)(ws + WS_KSUM); float* SSQ = (float*)(ws + WS_SSQ); const float* NRM = (const float*)(ws + WS_NRM);
        const int bh = F.vcu >> 2, c4 = F.vcu & 3, b = bh >> 3, h = bh & 7;
#if MOBA_SPARSE
        att::moba_gate(QKV, KSUM, (int*)(ws + WS_CNTQ), (int*)(ws + WS_LQ), F.vcu * 512 + F.tid, F.G * 512, F.lane);
#if PROBE_MOBA == 1
        att::moba_gate(QKV, KSUM, (int*)(ws + WS_CNTQ) + 1024, (int*)(ws + WS_PO), F.vcu * 512 + F.tid, F.G * 512, F.lane);
#endif
        xcd_barrier(xbar);
#endif
        if (bh < BATCH * NH) att::head_tables(b, h, KSUM, (char*)lds, F.tid);
#if MOBA_SPARSE
        if (bh < BATCH * NH) { int s0 = 0;
            for (int i = 0; i < 4; ++i) { const int qb = (i == 0) ? c4 : (i == 1) ? 7 - c4 : (i == 2) ? 8 + c4 : 15 - c4;
                s0 = att::attn_unit<true, 8>(b, h, qb, 4 * qb + 4, QKV, QKV + 512, QKV + 1024, OB, CB, KSUM, NRM, SSQ, (char*)lds, 0, false, att::AttNext{nullptr, nullptr, 0, 0, 0, 0}, (int*)(ws + WS_PRDY)); } (void)s0; }
#else
        if (bh < BATCH * NH) {
            int* fqc = (int*)(ws + WS_PRDY) + 150; volatile LAS int* fslot = (volatile LAS int*)(F.lds + LDSX_OFF + 56); int npull = 0;
#define FOX_PULL(dst) do { if (F.tid == 0) fslot[npull & 1] = __hip_atomic_fetch_add(fqc, 1, __ATOMIC_RELAXED, __HIP_MEMORY_SCOPE_AGENT); \
            asm volatile("s_waitcnt lgkmcnt(0)" ::: "memory"); __builtin_amdgcn_s_barrier(); asm volatile("" ::: "memory"); dst = fslot[npull & 1]; ++npull; } while (0)
            int fu; FOX_PULL(fu);
            int s0 = 0; bool pre = false; int pub = -1;
            for (int i = 0; i < 4; ++i) {
                const int qb = (i == 0) ? 15 - c4 : (i == 1) ? 8 + c4 : (i == 2) ? 7 - c4 : c4, qb1 = (i == 0) ? 8 + c4 : (i == 1) ? 7 - c4 : c4;
                const att::AttNext nx = (i < 3) ? att::AttNext{QKV + 4 * KIND, QKV + 5 * KIND, b, h, qb1, 1} : att::AttNext{QKV + 1 * KIND, QKV + 2 * KIND, (fu & 63) >> 3, fu & 7, 15 - (fu >> 6), fu < 1024 ? 1 : 0};
                s0 = att::attn_unit<false, 8>(b, h, qb, 4 * qb + 4, QKV + 3 * KIND, QKV + 4 * KIND, QKV + 5 * KIND, OB + 512, CB, KSUM, NRM, SSQ + 8, (char*)lds, s0, pre, nx, (int*)(ws + WS_PRDY), pub);
                pre = true; }
            while (fu < 1024) {
                int fn; FOX_PULL(fn);
                const att::AttNext nx{QKV + 1 * KIND, QKV + 2 * KIND, (fn & 63) >> 3, fn & 7, 15 - (fn >> 6), fn < 1024 ? 1 : 0};
                const int qb = 15 - (fu >> 6);
                s0 = att::attn_unit<true, 8>((fu & 63) >> 3, fu & 7, qb, 4 * qb + 4, QKV, QKV + 1 * KIND, QKV + 2 * KIND, OB, CB, KSUM, NRM, SSQ, (char*)lds, s0, pre, nx, (int*)(ws + WS_PRDY), pub);
                fu = fn; }
            att::publish((int*)(ws + WS_PRDY), pub);
#undef FOX_PULL
        }
#endif
    }

    if (IN(3)) {
        if (blockIdx.x == 0 && F.tid < NEXP) ((int*)(ws + WS_CNT))[F.tid] = 0;
        if (blockIdx.x == 0) { ((int*)(ws + WS_TRDY))[F.tid] = 0; ((int*)(ws + WS_TRDY))[512 + F.tid] = 0; }
        OutOrder S{(const char*)(ws + WS_O), (const char*)(ws + WS_WOT), (int*)(ws + WS_PRDY) + 256, (int*)(ws + WS_PRDY), (volatile LAS int*)(F.lds + LDSX_OFF + 48), (int)xbar.x, 0, 0};
        EpiOut E{F.x, (half_t*)(ws + WS_XH), (const float*)(ws + WS_SSQ), (LAS f32x2*)(F.lds + LDSX_OFF + LX_RTOK), args.pad ? ws + WS_Y + 64 * MiB : ws + WS_H8, args.pad ? (half_t*)(ws + WS_Y) : (half_t*)(ws + WS_XH)};
        pg8::gemm_phase<EpiOut, OutOrder, true>(F.lds, DM, S, E);
        if (IN(4)) p4_fill(F);
        SEAM(3);
    }

    if (IN(4)) { if (!IN(3)) p4_fill(F); p4_router(F); SEAM(4); }

#ifndef PROBE_MOE_REP
#define PROBE_MOE_REP 1
#endif
_Pragma("unroll")
    for (int mrep_ = 0; mrep_ < PROBE_MOE_REP; ++mrep_) {
#ifndef PROBE_UP_REP
#define PROBE_UP_REP 1
#endif
_Pragma("unroll")
    for (int urep_ = 0; urep_ < PROBE_UP_REP; ++urep_)
    if (IN(5)) {
        moe_tile_table(F);
        const LAS int* toff = (const LAS int*)(F.lds + LDSX_OFF + LX_TOFF);
        LAS int* rtok = (LAS int*)(F.lds + LDSX_OFF + LX_RTOK); LAS float* rrs = (LAS float*)(F.lds + LDSX_OFF + LX_RRS); LAS float* rcw = (LAS float*)(F.lds + LDSX_OFF + LX_RCW);
        const int nunits = toff[NEXP] * 2;
        const int* CNT = (const int*)(ws + WS_CNT); const int* LTOK = (const int*)(ws + WS_LTOK); const float* LRS = (const float*)(ws + WS_LRS); const float* LCW = (const float*)(ws + WS_LCW);
        for (int i = 0; i < MAXU; ++i) { const int U = F.vcu + F.G * i;
            if (U < nunits && F.tid < 256) { const int tile = U >> 1, e = moe_find_expert(toff, tile), idx = (tile - toff[e]) * 256 + F.tid; const bool ok = idx < __hip_atomic_load(CNT + e, __ATOMIC_RELAXED, __HIP_MEMORY_SCOPE_AGENT);
                rtok[i * 256 + F.tid] = ok ? LTOK[(size_t)e * T + idx] : 0; rrs[i * 256 + F.tid] = ok ? LRS[(size_t)e * T + idx] : 0.f; rcw[i * 256 + F.tid] = ok ? LCW[(size_t)e * T + idx] : 0.f; } }
        __syncthreads();
        MoeUpOrder S{(const char*)(ws + WS_H8), (const char*)(ws + WS_WGU), toff, rtok, F.G, F.vcu, nunits};
        EpiMoeUp E{(half_t*)(ws + WS_ACT), rrs, rcw, urep_ == PROBE_UP_REP - 1 ? (int*)(ws + WS_TRDY) : nullptr};
        pg8::gemm_phase<EpiMoeUp, MoeUpOrder, true, true>(F.lds, DM / 2, S, E);
    }

#ifndef PROBE_DN_REP
#define PROBE_DN_REP 1
#endif
_Pragma("unroll")
    for (int drep_ = 0; drep_ < PROBE_DN_REP; ++drep_)
    if (IN(6)) {
        if (drep_) xcd_barrier(xbar);
        if (!IN(5)) moe_tile_table(F);
        const LAS int* toff = (const LAS int*)(F.lds + LDSX_OFF + LX_TOFF);
        MoeDownOrder S{(const char*)(ws + WS_ACT), (const char*)(ws + WS_WD), toff, (int*)(ws + WS_TRDY) + 512 + mrep_ + drep_, (int*)(ws + WS_TRDY), (volatile LAS int*)(F.lds + LDSX_OFF + 40), toff[NEXP] * 4, 0, 0, 0, 0, 0};
        EpiMoeDown E{drep_ == PROBE_DN_REP - 1 ? (half_t*)(ws + WS_Y) : nullptr};
        pg8::gemm_phase<EpiMoeDown, MoeDownOrder, true, true>(F.lds, DEXP / 2, S, E);
        if (drep_ == PROBE_DN_REP - 1) { if (mrep_ == PROBE_MOE_REP - 1) SEAM(6); else xcd_barrier(xbar); }
    }
    }

#ifdef PROBE_SYNCS
    if (IN(7)) { for (int i_ = 0; i_ < PROBE_SYNCS; ++i_) xcd_barrier(xbar); }
#endif
    if (IN(7)) { if (!IN(5) && !IN(6)) moe_tile_table(F); p7_final(F); }
#undef IN
#undef SEAM
}

__device__ __forceinline__ void nk_toff(const int* CNT, int* toff) { int a = 0; for (int e = 0; e < NEXP; ++e) { toff[e] = a; a += (CNT[e] + 255) >> 8; } toff[NEXP] = a; }
__global__ void __launch_bounds__(256) nk_moe_up(const half_t* __restrict__ H2, const float* __restrict__ g, const float* __restrict__ wg, const float* __restrict__ wu,
                                                  const int* CNT, const int* LTOK, const float* LRS, const float* LCW, half_t* ACT) {
    __shared__ int toff[NEXP + 1]; __shared__ float hs[DM];
    const int tid = threadIdx.x, row = blockIdx.x;
    if (tid == 0) nk_toff(CNT, toff);
    __syncthreads();
    const int tile = row >> 8; if (tile >= toff[NEXP]) return;
    int e = 0; for (int k = 1; k < NEXP; ++k) if (toff[k] <= tile) e = k;
    const int idx = (tile - toff[e]) * 256 + (row & 255);
    if (idx >= CNT[e]) { ACT[(size_t)row * DEXP + tid] = (half_t)0.f; return; }
    const int tok = LTOK[(size_t)e * T + idx]; const float rs = LRS[(size_t)e * T + idx], cw = LCW[(size_t)e * T + idx];
    for (int k = tid; k < DM; k += 256) hs[k] = (float)H2[(size_t)tok * DM + k] * g[k];
    __syncthreads();
    const float* pg = wg + (size_t)e * DM * DEXP + tid; const float* pu = wu + (size_t)e * DM * DEXP + tid;
    float a = 0.f, u = 0.f;
    for (int k = 0; k < DM; ++k) { a += hs[k] * pg[(size_t)k * DEXP]; u += hs[k] * pu[(size_t)k * DEXP]; }
    a *= rs; u *= rs;
    ACT[(size_t)row * DEXP + tid] = (half_t)(a / (1.0f + expf(-a)) * u * cw);
}
__global__ void __launch_bounds__(256) nk_moe_down(const half_t* __restrict__ ACT, const float* __restrict__ wd, const int* CNT, half_t* Y) {
    __shared__ int toff[NEXP + 1]; __shared__ float as[DEXP];
    const int tid = threadIdx.x, row = blockIdx.x;
    if (tid == 0) nk_toff(CNT, toff);
    __syncthreads();
    const int tile = row >> 8; if (tile >= toff[NEXP]) return;
    int e = 0; for (int k = 1; k < NEXP; ++k) if (toff[k] <= tile) e = k;
    as[tid] = (float)ACT[(size_t)row * DEXP + tid];
    __syncthreads();
    const float* pd = wd + (size_t)e * DEXP * DM;
    float y[4] = {0.f, 0.f, 0.f, 0.f};
    for (int f = 0; f < DEXP; ++f) { const float av = as[f];
#pragma unroll
        for (int j = 0; j < 4; ++j) y[j] += av * pd[(size_t)f * DM + tid + 256 * j]; }
#pragma unroll
    for (int j = 0; j < 4; ++j) Y[(size_t)row * DM + tid + 256 * j] = (half_t)y[j];
}
__global__ void __launch_bounds__(256) nk_moe_final(const TokInfo* __restrict__ tok, const int* CNT, const half_t* __restrict__ Y, const float* __restrict__ gfin, float* out) {
    __shared__ int toff[NEXP + 1]; __shared__ float red[4];
    const int tid = threadIdx.x, lane = tid & 63, wid = tid >> 6, row = blockIdx.x;
    if (tid == 0) nk_toff(CNT, toff);
    __syncthreads();
    const TokInfo ti = tok[row];
    const size_t r1 = (size_t)toff[ti.e1] * 256 + ti.pad0, r2 = (size_t)toff[ti.e2] * 256 + ti.pad1;
    float y[4]; float ss = 0.f;
#pragma unroll
    for (int j = 0; j < 4; ++j) { const int k = tid + 256 * j; y[j] = out[(size_t)row * DM + k] + (float)Y[r1 * DM + k] + (float)Y[r2 * DM + k]; ss += y[j] * y[j]; }
    ss = wave_sum(ss); if (lane == 0) red[wid] = ss;
    __syncthreads();
    const float rs = 1.0f / sqrtf((red[0] + red[1] + red[2] + red[3]) * (1.0f / DM) + EPS);
#pragma unroll
    for (int j = 0; j < 4; ++j) { const int k = tid + 256 * j; out[(size_t)row * DM + k] = y[j] * rs * gfin[k]; }
}

#ifndef SPLITMASK
#define SPLITMASK 0x00
#endif
#ifndef OPTMASK
#define OPTMASK 0xFF
#endif
extern "C" void kernel_launch(void* const* d_in, const int* in_sizes, int n_in, void* d_out, int out_size, void* d_ws, size_t ws_size, hipStream_t stream) {
    if (n_in != 16 || ws_size < WS_END2 || out_size != T * DM) { fprintf(stderr, "kernel_launch: unexpected n_in %d / ws %zu / out %d\n", n_in, ws_size, out_size); return; }
    const float* x = (const float*)d_in[0]; const float* norm_mix_g = (const float*)d_in[1]; const float* w_in = (const float*)d_in[2];
    const float* b_forget = (const float*)d_in[3]; const float* fox_g = (const float*)d_in[4]; const float* moba_g = (const float*)d_in[5];
    const float* w_out = (const float*)d_in[6]; const float* norm_ffn_g = (const float*)d_in[7]; const float* wrg = (const float*)d_in[8];
    const float* brg = (const float*)d_in[9]; const float* wre = (const float*)d_in[10]; const float* bre = (const float*)d_in[11];
    const float* wg = (const float*)d_in[12]; const float* wu = (const float*)d_in[13]; const float* wd = (const float*)d_in[14];
    const float* gfin = (const float*)d_in[15];
    float* out = (float*)d_out; unsigned char* ws = (unsigned char*)d_ws;
    half_t* QKV = (half_t*)(ws + WS_QKV); half_t* OB = (half_t*)(ws + WS_O);
    float* RSTD1 = (float*)(ws + WS_RSTD1); float* LOGF = (float*)(ws + WS_LOGF); float* CB = (float*)(ws + WS_CB);
    float* KSUM = (float*)(ws + WS_KSUM); float* SSQ = (float*)(ws + WS_SSQ); TokInfo* TOK = (TokInfo*)(ws + WS_TOK); float2* ROPE = (float2*)(ws + WS_ROPE);

    static int grid = 0;
    if (grid == 0) {
        int dev = 0, cus = 0, per_cu = 0;
        hipGetDevice(&dev); hipDeviceGetAttribute(&cus, hipDeviceAttributeMultiprocessorCount, dev);
        if (hipFuncSetAttribute((const void*)fwd_mega, hipFuncAttributeMaxDynamicSharedMemorySize, LDS_BYTES) != hipSuccess) { fprintf(stderr, "kernel_launch: hipFuncSetAttribute failed\n"); grid = -1; return; }
        if (hipOccupancyMaxActiveBlocksPerMultiprocessor(&per_cu, (const void*)fwd_mega, NWAVES * 64, LDS_BYTES) != hipSuccess || per_cu < 1) { fprintf(stderr, "kernel_launch: occupancy query says %d\n", per_cu); per_cu = 1; }
        (void)hipGetLastError();
        grid = cus;
        if (grid != 256) fprintf(stderr, "kernel_launch: %d CUs (built for 256)\n", grid);
    }
    if (grid < 0) return;
    Args a{};
    for (int i = 0; i < 16; ++i) a.in[i] = (const float*)d_in[i];
    a.out = out; a.ws = ws;
    for (int i = 0; i < 8; ++i) a.inv_freq[i] = pow(500000.0, -(double)i / 8.0);
    RopeArgs ra{}; for (int i = 0; i < 8; ++i) ra.inv_freq[i] = a.inv_freq[i];
    unsigned mask = OPTMASK; if (mask) mask |= 1u;
    if (hipMemsetAsync(ws + WS_CTL, 0, 8 * XCD_BAR_WORDS * 4, stream) != hipSuccess) { fprintf(stderr, "kernel_launch: memset of the barrier words failed\n"); return; }
    int n_launch = 0;
    int dupflag = 0;
    auto launch_opt = [&](int lo, int hi) { a.ph_lo = lo; a.ph_hi = hi; a.li = n_launch++; a.pad = dupflag;
        hipLaunchKernelGGL(fwd_mega, dim3(grid), dim3(NWAVES * 64), LDS_BYTES, stream, a);
        const hipError_t e = hipPeekAtLastError();
        if (e != hipSuccess) fprintf(stderr, "kernel_launch: launch [%d,%d) failed: %s\n", lo, hi, hipGetErrorString(e)); };
#ifdef PROBE_DUP
    launch_opt(0, PROBE_DUP + 1);
    { const int dlo = PROBE_DLO, dhi = PROBE_DUP + 1;
      if (dlo == 1) hipMemsetAsync(ws + WS_KSUM, 0, (size_t)BATCH * NBLK * 512 * 4, stream);
      if (dlo > 0 && dlo <= 2 && 2 < dhi) hipMemsetAsync(ws + WS_PRDY, 0, 4096, stream);
      if (dlo == 3) hipMemsetAsync(ws + WS_PRDY + 256 * 4, 0, 1024, stream);
      if (dlo == 4) hipMemsetAsync(ws + WS_CNT, 0, 128, stream);
      if (dlo >= 4 && 6 < dhi) hipMemsetAsync(ws + WS_TRDY + 512 * 4, 0, 4, stream);
      dupflag = 1; launch_opt(dlo, dhi); dupflag = 0; }
    if (PROBE_DUP + 1 < NPHASE) launch_opt(PROBE_DUP + 1, NPHASE);
    return;
#endif
    int p = 0;
    while (p < NPHASE) {
        if ((mask >> p) & 1u) { int q = p; while (q < NPHASE && ((mask >> q) & 1u) && !(q > p && ((SPLITMASK >> q) & 1u))) ++q; launch_opt(p, q);
            if (p == 0 && !(OPTMASK & 1u)) { nk_rope<<<SEQ * 8 / 256, 256, 0, stream>>>(ROPE, ra); nk_rowstats<<<T, 256, 0, stream>>>(x, norm_mix_g, w_in, b_forget, RSTD1, LOGF); }
            p = q; continue; }
        switch (p) {
        case 0: nk_rope<<<SEQ * 8 / 256, 256, 0, stream>>>(ROPE, ra); nk_rowstats<<<T, 256, 0, stream>>>(x, norm_mix_g, w_in, b_forget, RSTD1, LOGF); break;
        case 1: nk_cumsum<<<1, 64, 0, stream>>>(LOGF, CB);
                nk_gemm<<<dim3(NQKV / 64, T / 64), 256, 0, stream>>>(DM, InA{x, norm_mix_g}, InB{w_in}, InS{RSTD1, QKV});
                nk_rotary<<<(unsigned)(((size_t)T * 128 + 255) / 256), 256, 0, stream>>>(QKV, ROPE);
                nk_ksum<<<dim3(BATCH * 16, 2), 256, 0, stream>>>(QKV, KSUM); break;
        case 2: nk_attn<true><<<T * 8 / 4, 256, 0, stream>>>(QKV, CB, KSUM, OB, SSQ); nk_attn<false><<<T * 8 / 4, 256, 0, stream>>>(QKV, CB, KSUM, OB, SSQ); break;
        case 3: nk_gemm<<<dim3(DM / 64, T / 64), 256, 0, stream>>>(DM, OutA{OB, SSQ, fox_g, moba_g}, OutB{w_out}, OutS{x, out}); break;
        case 4: nk_router<<<T, 256, 0, stream>>>(out, norm_ffn_g, wrg, brg, wre, bre, TOK); break;
        case 5: if (!((mask >> 4) & 1u)) { nk_moe<<<T, 256, 0, stream>>>(out, norm_ffn_g, TOK, wg, wu, wd, gfin, out); p = NPHASE; }
                else nk_moe_up<<<73728, 256, 0, stream>>>((const half_t*)(ws + WS_XH), norm_ffn_g, wg, wu, (const int*)(ws + WS_CNT), (const int*)(ws + WS_LTOK), (const float*)(ws + WS_LRS), (const float*)(ws + WS_LCW), (half_t*)(ws + WS_ACT));
                break;
        case 6: nk_moe_down<<<73728, 256, 0, stream>>>((const half_t*)(ws + WS_ACT), wd, (const int*)(ws + WS_CNT), (half_t*)(ws + WS_Y)); break;
        case 7: nk_moe_final<<<T, 256, 0, stream>>>(TOK, (const int*)(ws + WS_CNT), (const half_t*)(ws + WS_Y), gfin, out); break;
        default: break;
        }
        ++p;
    }
}
```
